# Optimizing an MI355X kernel written in HIP

```python
import math
import jax, jax.numpy as jnp
from jax import lax
import numpy as np

D_MODEL = 1024
BATCH = 8
SEQ = 2048
DEPTH = 2

MIX_WIDTH = D_MODEL
GROUP_WIDTH = MIX_WIDTH // 4
HEAD_DIM = 64
H_A = GROUP_WIDTH // HEAD_DIM
H_IDX = 4
D_IDX = 64
TOPK_MAX = 256
H_B = GROUP_WIDTH // HEAD_DIM
MLA_Q_RANK = 256
MLA_KV_RANK = 128
MLA_NOPE = 64
MLA_ROPE = 32
MLA_V = 64
ROPE_THETA = 10000.0
H_C = GROUP_WIDTH // HEAD_DIM
S5_GROUP_CH = 16
S5_GROUPS = GROUP_WIDTH // S5_GROUP_CH
S5_STATE = 64
REL_BUCKETS = 32
REL_MAX_DIST = 128
PEER_HEADS = 8
PEER_KEYS = 128
PEER_N = PEER_KEYS * PEER_KEYS
PEER_DKEY = 256
PEER_TOPK = 16
PEER_CHUNK = 128
Q_BLOCK = 128
EPS = 1e-6
IN_SIZES = (H_A * HEAD_DIM, H_A * HEAD_DIM, H_A * HEAD_DIM,
            H_IDX * D_IDX, D_IDX, H_IDX,
            MLA_Q_RANK, MLA_KV_RANK, MLA_ROPE,
            H_C * HEAD_DIM, H_C * HEAD_DIM, H_C * HEAD_DIM, H_C,
            GROUP_WIDTH)
IN_WIDTH = sum(IN_SIZES)

kernel_name = "hybrid_dsa_mla_fox_s5_peer_block"


def rmsnorm(x, g):
    xf = x.astype(jnp.float32)
    y = xf * lax.rsqrt(jnp.mean(xf * xf, axis=-1, keepdims=True) + EPS)
    return (y * g.astype(jnp.float32)).astype(x.dtype)


def rel_bucket(n):
    max_exact = REL_BUCKETS // 2
    n = jnp.maximum(n, 0)
    nf = jnp.maximum(n, 1).astype(jnp.float32)
    log_ratio = jnp.log(nf / max_exact) / math.log(REL_MAX_DIST / max_exact)
    large = max_exact + (log_ratio * (REL_BUCKETS - max_exact)).astype(jnp.int32)
    return jnp.where(n < max_exact, n, jnp.minimum(large, REL_BUCKETS - 1))


def rope(x, pos):
    half = x.shape[-1] // 2
    freqs = ROPE_THETA ** (-jnp.arange(half, dtype=jnp.float32) / half)
    ang = pos.astype(jnp.float32)[..., None] * freqs
    cos, sin = jnp.cos(ang)[:, :, None, :], jnp.sin(ang)[:, :, None, :]
    x1, x2 = x[..., :half], x[..., half:]
    return jnp.concatenate([x1 * cos - x2 * sin, x1 * sin + x2 * cos], axis=-1).astype(x.dtype)


def blocked_causal_attention(q, k, v, scale, bias_fn=None):
    S = q.shape[1]
    outs = []
    for i in range(S // Q_BLOCK):
        q0, q1 = i * Q_BLOCK, (i + 1) * Q_BLOCK
        logits = jnp.einsum('bqhd,bkhd->bhqk', q[:, q0:q1], k[:, :q1]).astype(jnp.float32) * scale
        if bias_fn is not None:
            logits = logits + bias_fn(q0, q1)
        causal = (q0 + jnp.arange(Q_BLOCK))[:, None] >= jnp.arange(q1)[None, :]
        logits = jnp.where(causal, logits, -jnp.inf)
        p = jax.nn.softmax(logits, axis=-1).astype(v.dtype)
        outs.append(jnp.einsum('bhqk,bkhd->bqhd', p, v[:, :q1]))
    return jnp.concatenate(outs, axis=1)


def dsa_attention(q, k, v, q_idx, k_idx, w_idx, positions, rel_bias):
    S = q.shape[1]
    topk = min(TOPK_MAX, S // 4)
    scale = HEAD_DIM ** -0.5
    gather = jax.vmap(lambda table, idx: table[idx])
    outs = []
    for i in range(S // Q_BLOCK):
        q0, q1 = i * Q_BLOCK, (i + 1) * Q_BLOCK
        kk = min(topk, q1)
        tq = q0 + jnp.arange(Q_BLOCK)
        causal = tq[:, None] >= jnp.arange(q1)[None, :]
        dots = jnp.einsum('bqhd,bkd->bqhk', q_idx[:, q0:q1], k_idx[:, :q1])
        score = jnp.einsum('bqh,bqhk->bqk', w_idx[:, q0:q1], jax.nn.relu(dots)).astype(jnp.float32)
        score = jnp.where(causal, score, -jnp.inf)
        _, sel = lax.top_k(score, kk)
        valid = sel <= tq[None, :, None]
        k_sel = gather(k, sel)
        v_sel = gather(v, sel)
        dist = positions[:, q0:q1, None] - gather(positions, sel)
        bias = jnp.swapaxes(rel_bias[rel_bucket(dist)], -1, -2)
        logits = (jnp.einsum('bqhd,bqkhd->bqhk', q[:, q0:q1], k_sel).astype(jnp.float32) * scale
                  + bias.astype(jnp.float32))
        logits = jnp.where(valid[:, :, None, :], logits, -jnp.inf)
        p = jax.nn.softmax(logits, axis=-1).astype(v.dtype)
        outs.append(jnp.einsum('bqhk,bqkhd->bqhd', p, v_sel))
    return jnp.concatenate(outs, axis=1)


def mla_attention(cq, ckv, kr, q_norm_g, kv_norm_g, w_uq, w_ukv, positions):
    B, S, _ = cq.shape
    q = (rmsnorm(cq, q_norm_g) @ w_uq).reshape(B, S, H_B, MLA_NOPE + MLA_ROPE)
    kv = (rmsnorm(ckv, kv_norm_g) @ w_ukv).reshape(B, S, H_B, MLA_NOPE + MLA_V)
    q = jnp.concatenate([q[..., :MLA_NOPE], rope(q[..., MLA_NOPE:], positions)], axis=-1)
    k_rope = jnp.broadcast_to(rope(kr[:, :, None, :], positions), (B, S, H_B, MLA_ROPE))
    k = jnp.concatenate([kv[..., :MLA_NOPE], k_rope], axis=-1)
    v = kv[..., MLA_NOPE:]
    return blocked_causal_attention(q, k, v, (MLA_NOPE + MLA_ROPE) ** -0.5)


def forgetting_attention(q, k, v, f_logit, b_f):
    log_f = jax.nn.log_sigmoid(f_logit.astype(jnp.float32) + b_f.astype(jnp.float32))
    cum = jnp.swapaxes(jnp.cumsum(log_f, axis=1), 1, 2)

    def bias_fn(q0, q1):
        return cum[:, :, q0:q1, None] - cum[:, :, None, :q1]

    return blocked_causal_attention(q, k, v, HEAD_DIM ** -0.5, bias_fn)


def _complex_scan_combine(e1, e2):
    a1r, a1i, b1r, b1i = e1
    a2r, a2i, b2r, b2i = e2
    return (a2r * a1r - a2i * a1i,
            a2r * a1i + a2i * a1r,
            a2r * b1r - a2i * b1i + b2r,
            a2r * b1i + a2i * b1r + b2i)


def s5_layer(u, A_re, A_im, log_dt, B_re, B_im, C_re, C_im, D, w_glu, b_glu):
    Bsz, S, _ = u.shape
    f32 = jnp.float32
    u32 = u.astype(f32)
    ug = u32.reshape(Bsz, S, S5_GROUPS, S5_GROUP_CH)
    lam_re, lam_im = A_re.astype(f32), A_im.astype(f32)
    dt = jnp.exp(log_dt.astype(f32))[:, None]
    mag = jnp.exp(lam_re * dt)
    a_re, a_im = mag * jnp.cos(lam_im * dt), mag * jnp.sin(lam_im * dt)
    den = lam_re * lam_re + lam_im * lam_im
    coef_re = ((a_re - 1.0) * lam_re + a_im * lam_im) / den
    coef_im = (a_im * lam_re - (a_re - 1.0) * lam_im) / den
    Br, Bi = B_re.astype(f32), B_im.astype(f32)
    bb_re = coef_re[..., None] * Br - coef_im[..., None] * Bi
    bb_im = coef_re[..., None] * Bi + coef_im[..., None] * Br
    bu_re = jnp.einsum('bsgh,gph->bsgp', ug, bb_re)
    bu_im = jnp.einsum('bsgh,gph->bsgp', ug, bb_im)
    elems = (jnp.broadcast_to(a_re, bu_re.shape), jnp.broadcast_to(a_im, bu_im.shape), bu_re, bu_im)
    _, _, x_re, x_im = lax.associative_scan(_complex_scan_combine, elems, axis=1)
    y = (jnp.einsum('bsgp,ghp->bsgh', x_re, C_re.astype(f32))
         - jnp.einsum('bsgp,ghp->bsgh', x_im, C_im.astype(f32)))
    y = y.reshape(Bsz, S, GROUP_WIDTH) + D.astype(f32) * u32
    g = jax.nn.gelu(y)
    out = g * jax.nn.sigmoid(g @ w_glu.astype(f32) + b_glu.astype(f32))
    return out.astype(u.dtype)


def hybrid_mixer(h, positions, rel_bias, w_in, mla_q_norm_g, mla_kv_norm_g, mla_w_uq, mla_w_ukv,
                 fox_b_f, s5_A_re, s5_A_im, s5_log_dt, s5_B_re, s5_B_im, s5_C_re, s5_C_im, s5_D,
                 s5_w_glu, s5_b_glu, group_norm_g, w_out):
    B, S, _ = h.shape
    proj = h @ w_in
    cuts = [int(v) for v in np.cumsum(IN_SIZES)[:-1]]
    (a_q, a_k, a_v, i_q, i_k, i_w, b_cq, b_ckv, b_kr,
     c_q, c_k, c_v, c_f, d_u) = jnp.split(proj, cuts, axis=-1)

    def heads(t, n):
        return t.reshape(B, S, n, -1)

    y_a = dsa_attention(heads(a_q, H_A), heads(a_k, H_A), heads(a_v, H_A),
                        heads(i_q, H_IDX), i_k, i_w, positions, rel_bias)
    y_b = mla_attention(b_cq, b_ckv, b_kr, mla_q_norm_g, mla_kv_norm_g, mla_w_uq, mla_w_ukv, positions)
    y_c = forgetting_attention(heads(c_q, H_C), heads(c_k, H_C), heads(c_v, H_C), c_f, fox_b_f)
    y_d = s5_layer(d_u, s5_A_re, s5_A_im, s5_log_dt, s5_B_re, s5_B_im, s5_C_re, s5_C_im, s5_D,
                   s5_w_glu, s5_b_glu)
    groups = jnp.stack([y_a.reshape(B, S, GROUP_WIDTH), y_b.reshape(B, S, GROUP_WIDTH),
                        y_c.reshape(B, S, GROUP_WIDTH), y_d], axis=2)
    groups = rmsnorm(groups, group_norm_g.reshape(4, GROUP_WIDTH))
    return groups.reshape(B, S, MIX_WIDTH) @ w_out


def peer_ffn(h, w_q, sk1, sk2, u_tab, v_tab):
    B, S, Dm = h.shape
    t = h.reshape(-1, Dm)
    T = t.shape[0]
    q = (t @ w_q).reshape(T, PEER_HEADS, 2, PEER_DKEY // 2)
    s1 = jnp.einsum('thd,kd->thk', q[:, :, 0], sk1).astype(jnp.float32)
    s2 = jnp.einsum('thd,kd->thk', q[:, :, 1], sk2).astype(jnp.float32)
    v1, i1 = lax.top_k(s1, PEER_TOPK)
    v2, i2 = lax.top_k(s2, PEER_TOPK)
    cand = (v1[..., :, None] + v2[..., None, :]).reshape(T, PEER_HEADS, PEER_TOPK * PEER_TOPK)
    vc, ic = lax.top_k(cand, PEER_TOPK)
    expert = (jnp.take_along_axis(i1, ic // PEER_TOPK, axis=-1) * PEER_KEYS
              + jnp.take_along_axis(i2, ic % PEER_TOPK, axis=-1))
    gate = jax.nn.softmax(vc, axis=-1)

    def chunk(args):
        tc, ec, gc = args
        a = jnp.einsum('td,thkd->thk', tc, u_tab[ec]).astype(jnp.float32)
        w = (gc * jax.nn.gelu(a)).astype(tc.dtype)
        return jnp.einsum('thk,thkd->td', w, v_tab[ec])

    n_chunks = T // PEER_CHUNK
    y = lax.map(chunk, (t.reshape(n_chunks, PEER_CHUNK, Dm),
                        expert.reshape(n_chunks, PEER_CHUNK, PEER_HEADS, PEER_TOPK),
                        gate.reshape(n_chunks, PEER_CHUNK, PEER_HEADS, PEER_TOPK)))
    return y.reshape(B, S, Dm)


def setup_inputs(seed: int = 0) -> dict:
    key = jax.random.key(seed)
    keys = jax.random.split(key, 40)
    counter = [0]
    f32 = jnp.float32

    def nk():
        k = keys[counter[0]]
        counter[0] += 1
        return k

    def nrm(shape, scale):
        return jax.random.normal(nk(), shape, f32) * scale

    def gain(shape):
        return 1.0 + nrm(shape, 0.05)

    L = DEPTH
    x = nrm((BATCH, SEQ, D_MODEL), 1.0)
    c = nrm((BATCH, D_MODEL), 1.0)
    offs = jax.random.randint(nk(), (BATCH, 1), 0, 1024, dtype=jnp.int32)
    positions = offs + jnp.arange(SEQ, dtype=jnp.int32)[None, :]
    rel_bias = nrm((REL_BUCKETS, H_A), 0.5)
    ada_w = nrm((L, D_MODEL, 6 * D_MODEL), 0.5 * D_MODEL ** -0.5)
    ada_b = nrm((L, 6 * D_MODEL), 0.01)
    norm1_g = gain((L, D_MODEL))
    w_in = nrm((L, D_MODEL, IN_WIDTH), D_MODEL ** -0.5)
    mla_q_norm_g = gain((L, MLA_Q_RANK))
    mla_kv_norm_g = gain((L, MLA_KV_RANK))
    mla_w_uq = nrm((L, MLA_Q_RANK, H_B * (MLA_NOPE + MLA_ROPE)), MLA_Q_RANK ** -0.5)
    mla_w_ukv = nrm((L, MLA_KV_RANK, H_B * (MLA_NOPE + MLA_V)), MLA_KV_RANK ** -0.5)
    fox_b_f = jax.random.uniform(nk(), (L, H_C), f32, 1.0, 4.0)
    s5_A_re = -0.5 + nrm((L, S5_GROUPS, S5_STATE), 0.01)
    s5_A_im = jnp.pi * jnp.arange(S5_STATE, dtype=f32) + nrm((L, S5_GROUPS, S5_STATE), 0.01)
    s5_log_dt = jax.random.uniform(nk(), (L, S5_GROUPS), f32, math.log(1e-3), math.log(1e-1))
    s5_B_re = nrm((L, S5_GROUPS, S5_STATE, S5_GROUP_CH), S5_GROUP_CH ** -0.5)
    s5_B_im = nrm((L, S5_GROUPS, S5_STATE, S5_GROUP_CH), S5_GROUP_CH ** -0.5)
    s5_C_re = nrm((L, S5_GROUPS, S5_GROUP_CH, S5_STATE), S5_STATE ** -0.5)
    s5_C_im = nrm((L, S5_GROUPS, S5_GROUP_CH, S5_STATE), S5_STATE ** -0.5)
    s5_D = nrm((L, GROUP_WIDTH), 1.0)
    s5_w_glu = nrm((L, GROUP_WIDTH, GROUP_WIDTH), GROUP_WIDTH ** -0.5)
    s5_b_glu = nrm((L, GROUP_WIDTH), 0.01)
    group_norm_g = gain((L, MIX_WIDTH))
    w_out = nrm((L, MIX_WIDTH, D_MODEL), MIX_WIDTH ** -0.5)
    norm2_g = gain((L, D_MODEL))
    peer_w_q = nrm((L, D_MODEL, PEER_HEADS * PEER_DKEY), D_MODEL ** -0.5)
    peer_subkeys1 = nrm((L, PEER_KEYS, PEER_DKEY // 2), (PEER_DKEY // 2) ** -0.5)
    peer_subkeys2 = nrm((L, PEER_KEYS, PEER_DKEY // 2), (PEER_DKEY // 2) ** -0.5)
    peer_u = nrm((L, PEER_N, D_MODEL), D_MODEL ** -0.5)
    peer_v = nrm((L, PEER_N, D_MODEL), 1.0)
    final_g = gain((D_MODEL,))
    return {"x": x, "c": c, "positions": positions, "rel_bias": rel_bias,
            "ada_w": ada_w, "ada_b": ada_b, "norm1_g": norm1_g, "w_in": w_in,
            "mla_q_norm_g": mla_q_norm_g, "mla_kv_norm_g": mla_kv_norm_g,
            "mla_w_uq": mla_w_uq, "mla_w_ukv": mla_w_ukv, "fox_b_f": fox_b_f,
            "s5_A_re": s5_A_re, "s5_A_im": s5_A_im, "s5_log_dt": s5_log_dt,
            "s5_B_re": s5_B_re, "s5_B_im": s5_B_im, "s5_C_re": s5_C_re, "s5_C_im": s5_C_im,
            "s5_D": s5_D, "s5_w_glu": s5_w_glu, "s5_b_glu": s5_b_glu,
            "group_norm_g": group_norm_g, "w_out": w_out, "norm2_g": norm2_g,
            "peer_w_q": peer_w_q, "peer_subkeys1": peer_subkeys1, "peer_subkeys2": peer_subkeys2,
            "peer_u": peer_u, "peer_v": peer_v, "final_g": final_g}


def reference(x, c, positions, rel_bias, ada_w, ada_b, norm1_g, w_in, mla_q_norm_g, mla_kv_norm_g,
              mla_w_uq, mla_w_ukv, fox_b_f, s5_A_re, s5_A_im, s5_log_dt, s5_B_re, s5_B_im,
              s5_C_re, s5_C_im, s5_D, s5_w_glu, s5_b_glu, group_norm_g, w_out, norm2_g,
              peer_w_q, peer_subkeys1, peer_subkeys2, peer_u, peer_v, final_g):
    for l in range(DEPTH):
        mod = jax.nn.silu(c) @ ada_w[l] + ada_b[l]
        sh1, sc1, g1, sh2, sc2, g2 = jnp.split(mod[:, None, :], 6, axis=-1)
        h = rmsnorm(x, norm1_g[l]) * (1.0 + sc1) + sh1
        x = x + g1 * hybrid_mixer(h, positions, rel_bias, w_in[l], mla_q_norm_g[l], mla_kv_norm_g[l],
                                  mla_w_uq[l], mla_w_ukv[l], fox_b_f[l], s5_A_re[l], s5_A_im[l],
                                  s5_log_dt[l], s5_B_re[l], s5_B_im[l], s5_C_re[l], s5_C_im[l],
                                  s5_D[l], s5_w_glu[l], s5_b_glu[l], group_norm_g[l], w_out[l])
        h = rmsnorm(x, norm2_g[l]) * (1.0 + sc2) + sh2
        x = x + g2 * peer_ffn(h, peer_w_q[l], peer_subkeys1[l], peer_subkeys2[l], peer_u[l], peer_v[l])
    return rmsnorm(x, final_g)
```

```cpp
#include <hip/hip_runtime.h>
#include <cstdio>
#include <cstdint>

#ifndef MK_MULTI
#define MK_MULTI 0
#endif

constexpr int DM = 1024, NB = 8, SEQ = 2048, T = NB * SEQ, DEPTH = 2;
constexpr int INW = 2536;
constexpr int OA_Q = 0, OA_K = 256, OA_V = 512, OI_Q = 768, OI_K = 1024, OI_W = 1088, OB_CQ = 1092, OB_CKV = 1348, OB_KR = 1476,
              OC_Q = 1508, OC_K = 1764, OC_V = 2020, OC_F = 2276, OD_U = 2280;
constexpr int NTHR = 512, NWAVES = 8;
constexpr int LDS_BYTES = 147456;
constexpr float EPS = 1e-6f;

constexpr size_t MiB = 1u << 20;
constexpr size_t WS_CTL = 0, CTL_ZERO_BYTES = 1 * MiB;
constexpr size_t WS_MOD = 1 * MiB;
constexpr size_t WS_H = 2 * MiB;
constexpr size_t WS_PROJ = 66 * MiB;
constexpr size_t WS_MASK = 226 * MiB;
constexpr size_t WS_QN = 230 * MiB;
constexpr size_t WS_KVN = 246 * MiB;
constexpr size_t WS_MQ = 254 * MiB;
constexpr size_t WS_MKV = 278 * MiB;
constexpr size_t WS_KR = 310 * MiB;
constexpr size_t WS_CUM = 312 * MiB;
constexpr size_t WS_GRP = 313 * MiB;
constexpr size_t WS_SG = 377 * MiB;
constexpr size_t WS_SZ = 393 * MiB;
constexpr size_t WS_X = 409 * MiB;
constexpr size_t WS_PIDX = 473 * MiB;
constexpr size_t WS_PGATE = 481 * MiB;
constexpr size_t WS_END = 489 * MiB;

#define XB_TMO      128
#define XB_XCNT(j)  (256  + 64 * (j))
#define XB_XSUB(j)  (1280 + 64 * (j))
#define XB_XGEN(j)  (2304 + 64 * (j))
#define XB_TOP      3328
#define XB_TOPGEN   3392
#define XCD_BAR_WORDS 3456
#define XB_SPIN_CAP (1u << 18)
#define LAS __attribute__((address_space(3)))

__device__ __forceinline__ unsigned xb_ld(unsigned* p)              { return __hip_atomic_load(p, __ATOMIC_RELAXED, __HIP_MEMORY_SCOPE_AGENT); }
__device__ __forceinline__ unsigned xb_add(unsigned* p, unsigned v) { return __hip_atomic_fetch_add(p, v, __ATOMIC_RELAXED, __HIP_MEMORY_SCOPE_AGENT); }
__device__ __forceinline__ unsigned xb_xcc_id() { return (unsigned)__builtin_amdgcn_s_getreg((3 << 11) | 20) & 0xFu; }
#define XB_SPIN(cond, bar) do { unsigned _sp = 0; while (cond) { __builtin_amdgcn_s_sleep(1); \
    if ((++_sp & 255u) == 0u) { if (xb_ld(&(bar)[XB_TMO])) break; if (_sp > XB_SPIN_CAP) { atomicAdd(&(bar)[XB_TMO], 1u); break; } } } } while (0)

struct XcdBarrier { unsigned* bar; unsigned x; volatile LAS unsigned* st; };

__device__ __forceinline__ XcdBarrier xcd_barrier_post(unsigned* bar, volatile LAS unsigned* st) {
    XcdBarrier b; b.bar = bar; b.x = xb_xcc_id(); b.st = st;
    if (threadIdx.x == 0) (void)xb_add(&bar[XB_XCNT(b.x)], 1u);
    return b;
}
__device__ __forceinline__ void xcd_barrier_complete(unsigned* bar, unsigned x, unsigned& nloc, unsigned& nx) {
    const unsigned G = gridDim.x * gridDim.y * gridDim.z;
    unsigned sum, cnt, mine, sp = 0u;
    for (;;) {
        sum = 0u; cnt = 0u; mine = 0u;
#pragma unroll
        for (unsigned j = 0; j < 16; ++j) { const unsigned c = xb_ld(&bar[XB_XCNT(j)]); sum += c; cnt += (c > 0u) ? 1u : 0u; mine = (j == x) ? c : mine; }
        if (sum == G) break;
        __builtin_amdgcn_s_sleep(1);
        if ((++sp & 255u) == 0u) { if (xb_ld(&bar[XB_TMO])) break; if (sp > XB_SPIN_CAP) { atomicAdd(&bar[XB_TMO], 1u); break; } }
    }
    nloc = mine > 0u ? mine : 1u; nx = cnt > 0u ? cnt : 1u;
}
__device__ __forceinline__ void xcd_barrier(const XcdBarrier& b) {
    asm volatile("s_waitcnt vmcnt(0)" ::: "memory");
    __syncthreads();
    if (threadIdx.x == 0) {
        unsigned* bar = b.bar;
        __builtin_amdgcn_s_waitcnt(0);
        unsigned nloc = b.st[0], nx = b.st[1];
        if (nloc == 0u) { xcd_barrier_complete(bar, b.x, nloc, nx); b.st[0] = nloc; b.st[1] = nx; }
        const unsigned old = xb_add(&bar[XB_XSUB(b.x)], 1u);
        const unsigned gen = old / nloc;
        if (old + 1u == (gen + 1u) * nloc) {
            __builtin_amdgcn_fence(__ATOMIC_RELEASE, "agent");
            asm volatile("s_waitcnt vmcnt(0)" ::: "memory");
            const unsigned og = xb_add(&bar[XB_TOP], 1u);
            const unsigned tg = og / nx;
            if (og + 1u == (tg + 1u) * nx) xb_add(&bar[XB_TOPGEN], 1u);
            else XB_SPIN(xb_ld(&bar[XB_TOPGEN]) == tg, bar);
            __builtin_amdgcn_fence(__ATOMIC_ACQUIRE, "agent");
            xb_add(&bar[XB_XGEN(b.x)], 1u);
            asm volatile("s_waitcnt vmcnt(0)" ::: "memory");
        } else {
            XB_SPIN(xb_ld(&bar[XB_XGEN(b.x)]) == gen, bar);
            __builtin_amdgcn_fence(__ATOMIC_ACQUIRE, "agent");
            asm volatile("s_waitcnt vmcnt(0)" ::: "memory");
        }
    }
    __syncthreads();
}

struct Args { const float* in[32]; float* out; unsigned char* ws; int ph_lo, ph_hi; };
enum { I_X = 0, I_C, I_POS, I_RELB, I_ADAW, I_ADAB, I_N1G, I_WIN, I_MQG, I_MKVG, I_WUQ, I_WUKV, I_FOXB, I_SARE, I_SAIM, I_SLDT,
       I_SBRE, I_SBIM, I_SCRE, I_SCIM, I_SD, I_SWGLU, I_SBGLU, I_GNG, I_WOUT, I_N2G, I_PWQ, I_SK1, I_SK2, I_PU, I_PV, I_FING };

__device__ __forceinline__ int otid() { int t = threadIdx.x; asm volatile("" : "+v"(t)); return t; }
__device__ __forceinline__ float wave_sum(float v) {
#pragma unroll
    for (int o = 32; o > 0; o >>= 1) v += __shfl_xor(v, o);
    return v;
}
__device__ __forceinline__ float wave_max(float v) {
#pragma unroll
    for (int o = 32; o > 0; o >>= 1) v = fmaxf(v, __shfl_xor(v, o));
    return v;
}
__device__ __forceinline__ float gelu_tanh(float x) { return 0.5f * x * (1.f + tanhf(0.7978845608028654f * (x + 0.044715f * x * x * x))); }
__device__ __forceinline__ float sigmoidf_(float x) { return 1.f / (1.f + expf(-x)); }
__device__ __forceinline__ float4 ld4(const float* p) { return *(const float4*)p; }
__device__ __forceinline__ void st4(float* p, float4 v) { *(float4*)p = v; }

template <class Epi>
__device__ __forceinline__ void gemm_f32(const float* __restrict__ A, int lda, const float* __restrict__ B, int ldb, int M, int N, int K, float* lds, const Epi& epi) {
    constexpr int LDA = 132;
    float* As = lds; float* Bs = lds + 16 * LDA;
    const int tid = otid(), ty = tid >> 5, tx = tid & 31;
    const int nM = M / 128, nN = (N + 127) / 128;
    for (int u = blockIdx.x; u < nM * nN; u += gridDim.x) {
        const int m0 = (u % nM) * 128, n0 = (u / nM) * 128;
        float acc[8][4];
#pragma unroll
        for (int i = 0; i < 8; ++i)
#pragma unroll
            for (int j = 0; j < 4; ++j) acc[i][j] = 0.f;
        const int arow = tid >> 2, akq = (tid & 3) * 4, bk = tid >> 5, bn = (tid & 31) * 4;
        const bool bok = (n0 + bn) < N;
        for (int k0 = 0; k0 < K; k0 += 16) {
            const float4 av = ld4(A + (size_t)(m0 + arow) * lda + k0 + akq);
            float4 bv = make_float4(0.f, 0.f, 0.f, 0.f);
            if (bok) bv = ld4(B + (size_t)(k0 + bk) * ldb + n0 + bn);
            __syncthreads();
            As[(akq + 0) * LDA + arow] = av.x; As[(akq + 1) * LDA + arow] = av.y; As[(akq + 2) * LDA + arow] = av.z; As[(akq + 3) * LDA + arow] = av.w;
            st4(Bs + bk * 128 + bn, bv);
            __syncthreads();
#pragma unroll
            for (int kk = 0; kk < 16; ++kk) {
                const float4 a0 = ld4(As + kk * LDA + ty * 8), a1 = ld4(As + kk * LDA + ty * 8 + 4), b = ld4(Bs + kk * 128 + tx * 4);
                const float ar[8] = {a0.x, a0.y, a0.z, a0.w, a1.x, a1.y, a1.z, a1.w};
                const float br[4] = {b.x, b.y, b.z, b.w};
#pragma unroll
                for (int i = 0; i < 8; ++i)
#pragma unroll
                    for (int j = 0; j < 4; ++j) acc[i][j] = fmaf(ar[i], br[j], acc[i][j]);
            }
        }
        const int col = n0 + tx * 4;
        if (col < N) {
#pragma unroll
            for (int i = 0; i < 8; ++i) epi(m0 + ty * 8 + i, col, make_float4(acc[i][0], acc[i][1], acc[i][2], acc[i][3]));
        }
    }
    __syncthreads();
}
struct EpiStore { float* C; int ldc; __device__ __forceinline__ void operator()(int r, int c, float4 v) const { st4(C + (size_t)r * ldc + c, v); } };
struct EpiResGate { const float* Xin; float* Xout; const float* gate;
    __device__ __forceinline__ void operator()(int r, int c, float4 v) const {
        const float4 x = ld4(Xin + (size_t)r * DM + c); const float4 g = ld4(gate + (size_t)(r / SEQ) * 6144 + c);
        st4(Xout + (size_t)r * DM + c, make_float4(x.x + g.x * v.x, x.y + g.y * v.y, x.z + g.z * v.z, x.w + g.w * v.w)); } };

__device__ __forceinline__ void ph_mod(const Args& a, float* lds) {
    float* sc = lds;
    float* red = lds + 8192;
    float* MOD = (float*)(a.ws + WS_MOD);
    const int tid = otid();
    for (int i = tid; i < 8192; i += NTHR) { const float v = a.in[I_C][i]; sc[i] = v / (1.f + expf(-v)); }
    __syncthreads();
    const int cl = tid & 63, kq = tid >> 6;
    for (int u = blockIdx.x; u < DEPTH * 96; u += gridDim.x) {
        const int l = u / 96, col = (u % 96) * 64 + cl;
        const float* W = a.in[I_ADAW] + (size_t)l * DM * 6144 + col;
        float acc[8] = {0, 0, 0, 0, 0, 0, 0, 0};
        for (int k = kq * 128; k < kq * 128 + 128; ++k) { const float w = W[(size_t)k * 6144];
#pragma unroll
            for (int b = 0; b < 8; ++b) acc[b] = fmaf(sc[b * 1024 + k], w, acc[b]); }
        __syncthreads();
#pragma unroll
        for (int b = 0; b < 8; ++b) red[(kq * 8 + b) * 64 + cl] = acc[b];
        __syncthreads();
        { const int b = tid >> 6; float s = a.in[I_ADAB][l * 6144 + col];
#pragma unroll
          for (int q = 0; q < 8; ++q) s += red[(q * 8 + b) * 64 + cl];
          MOD[((size_t)l * 8 + b) * 6144 + col] = s; }
    }
    __syncthreads();
}

__device__ __forceinline__ void ph_modnorm(const Args& a, const float* X, const float* g, const float* mod_sh, const float* mod_sc, float* H) {
    const int tid_ = otid(); const int lane = tid_ & 63, wave = __builtin_amdgcn_readfirstlane(tid_ >> 6);
    for (int r = blockIdx.x * NWAVES + wave; r < T; r += gridDim.x * NWAVES) {
        const int b = r / SEQ; float4 v[4]; float s = 0.f;
#pragma unroll
        for (int j = 0; j < 4; ++j) { v[j] = ld4(X + (size_t)r * DM + lane * 4 + 256 * j); s += v[j].x * v[j].x + v[j].y * v[j].y + v[j].z * v[j].z + v[j].w * v[j].w; }
        const float rs = rsqrtf(wave_sum(s) * (1.f / DM) + EPS);
#pragma unroll
        for (int j = 0; j < 4; ++j) { const int c = lane * 4 + 256 * j; const float4 gg = ld4(g + c), sc = ld4(mod_sc + (size_t)b * 6144 + c), sh = ld4(mod_sh + (size_t)b * 6144 + c);
            st4(H + (size_t)r * DM + c, make_float4(v[j].x * rs * gg.x * (1.f + sc.x) + sh.x, v[j].y * rs * gg.y * (1.f + sc.y) + sh.y, v[j].z * rs * gg.z * (1.f + sc.z) + sh.z, v[j].w * rs * gg.w * (1.f + sc.w) + sh.w)); }
    }
}

template <int W>
__device__ __forceinline__ void rows_rmsnorm(const float* src, int ps, const float* g, float* dst) {
    const int tid_ = otid(); const int lane = tid_ & 63, wave = __builtin_amdgcn_readfirstlane(tid_ >> 6);
    constexpr int PER = W / 64;
    for (int r = blockIdx.x * NWAVES + wave; r < T; r += gridDim.x * NWAVES) {
        float v[PER]; float s = 0.f;
#pragma unroll
        for (int j = 0; j < PER; ++j) { v[j] = src[(size_t)r * ps + lane + 64 * j]; s += v[j] * v[j]; }
        const float rs = rsqrtf(wave_sum(s) * (1.f / W) + EPS);
#pragma unroll
        for (int j = 0; j < PER; ++j) dst[(size_t)r * W + lane + 64 * j] = v[j] * rs * g[lane + 64 * j];
    }
}

__device__ __forceinline__ void rope_pair(float x1, float x2, int pos, int i, float& o1, float& o2) {
    const float freq = powf(10000.f, -(float)i / 16.f); const float ang = (float)pos * freq; float sn, cs; sincosf(ang, &sn, &cs);
    o1 = x1 * cs - x2 * sn; o2 = x1 * sn + x2 * cs;
}

__device__ __forceinline__ void ph_dsa_mask(const Args& a, float* lds) {
    const int tid_ = otid(); const int lane = tid_ & 63, wave = __builtin_amdgcn_readfirstlane(tid_ >> 6);
    const float* PROJ = (const float*)(a.ws + WS_PROJ);
    unsigned long long* MASK = (unsigned long long*)(a.ws + WS_MASK);
    float* qs = lds + wave * 260;
    for (int r = blockIdx.x * NWAVES + wave; r < T; r += gridDim.x * NWAVES) {
        const int b = r / SEQ, t = r % SEQ;
        for (int i = lane; i < 260; i += 64) qs[i] = PROJ[(size_t)r * INW + OI_Q + i];
        __builtin_amdgcn_wave_barrier();
        if (lane < 4) qs[256 + lane] = PROJ[(size_t)r * INW + OI_W + lane];
        __builtin_amdgcn_wave_barrier();
        const float w0 = qs[256], w1 = qs[257], w2 = qs[258], w3 = qs[259];
        unsigned key[32];
        const int nw = t / 64 + 1;
#pragma unroll
        for (int j = 0; j < 32; ++j) {
            key[j] = 0u;
            if (j < nw) {
                const int s = j * 64 + lane;
                if (s <= t) {
                    const float* kr = PROJ + (size_t)(b * SEQ + s) * INW + OI_K;
                    float d0 = 0.f, d1 = 0.f, d2 = 0.f, d3 = 0.f;
#pragma unroll 4
                    for (int d = 0; d < 64; d += 4) { const float4 kv = ld4(kr + d);
                        const float4 q0 = ld4(qs + d), q1 = ld4(qs + 64 + d), q2 = ld4(qs + 128 + d), q3 = ld4(qs + 192 + d);
                        d0 = fmaf(q0.x, kv.x, d0); d0 = fmaf(q0.y, kv.y, d0); d0 = fmaf(q0.z, kv.z, d0); d0 = fmaf(q0.w, kv.w, d0);
                        d1 = fmaf(q1.x, kv.x, d1); d1 = fmaf(q1.y, kv.y, d1); d1 = fmaf(q1.z, kv.z, d1); d1 = fmaf(q1.w, kv.w, d1);
                        d2 = fmaf(q2.x, kv.x, d2); d2 = fmaf(q2.y, kv.y, d2); d2 = fmaf(q2.z, kv.z, d2); d2 = fmaf(q2.w, kv.w, d2);
                        d3 = fmaf(q3.x, kv.x, d3); d3 = fmaf(q3.y, kv.y, d3); d3 = fmaf(q3.z, kv.z, d3); d3 = fmaf(q3.w, kv.w, d3); }
                    float sc = w0 * fmaxf(d0, 0.f) + w1 * fmaxf(d1, 0.f) + w2 * fmaxf(d2, 0.f) + w3 * fmaxf(d3, 0.f);
                    sc += 0.f;
                    const unsigned ub = __float_as_uint(sc);
                    key[j] = (ub & 0x80000000u) ? ~ub : (ub | 0x80000000u);
                    if (key[j] == 0u) key[j] = 1u;
                }
            }
        }
        unsigned long long* mrow = MASK + (size_t)r * 32;
        if (t + 1 <= 256) {
#pragma unroll
            for (int j = 0; j < 32; ++j) { const unsigned long long m = __ballot(key[j] != 0u); if (lane == 0) mrow[j] = m; }
        } else {
            unsigned tau = 0u;
            for (int bit = 31; bit >= 0; --bit) {
                const unsigned cand = tau | (1u << bit); int cnt = 0;
#pragma unroll
                for (int j = 0; j < 32; ++j) cnt += __popcll(__ballot(key[j] >= cand));
                if (cnt >= 256) tau = cand;
            }
            int cgt = 0;
#pragma unroll
            for (int j = 0; j < 32; ++j) cgt += __popcll(__ballot(key[j] > tau));
            int need = 256 - cgt;
#pragma unroll
            for (int j = 0; j < 32; ++j) {
                unsigned long long mg = __ballot(key[j] > tau), me = __ballot(key[j] == tau);
                const int c = __popcll(me);
                if (c <= need) { mg |= me; need -= c; }
                else { while (need > 0) { const unsigned long long low = me & (~me + 1ull); mg |= low; me ^= low; --need; } }
                if (lane == 0) mrow[j] = mg;
            }
        }
    }
}

__device__ __forceinline__ void ph_fox_cum(const Args& a, int l) {
    const int tid_ = otid(); const int lane = tid_ & 63, wave = __builtin_amdgcn_readfirstlane(tid_ >> 6);
    const float* PROJ = (const float*)(a.ws + WS_PROJ); float* CUM = (float*)(a.ws + WS_CUM);
    for (int u = blockIdx.x * NWAVES + wave; u < NB * 4; u += gridDim.x * NWAVES) {
        const int b = u / 4, h = u % 4; const float bf = a.in[I_FOXB][l * 4 + h]; float carry = 0.f;
        for (int c = 0; c < SEQ / 64; ++c) {
            const int t = c * 64 + lane; const float z = PROJ[(size_t)(b * SEQ + t) * INW + OC_F + h] + bf;
            float v = fminf(z, 0.f) - log1pf(expf(-fabsf(z)));
#pragma unroll
            for (int o = 1; o < 64; o <<= 1) { const float n = __shfl_up(v, o); if (lane >= o) v += n; }
            v += carry; CUM[(size_t)(b * 4 + h) * SEQ + t] = v; carry = __shfl(v, 63);
        }
    }
}

__device__ __forceinline__ void ph_s5(const Args& a, int l, float* lds) {
    const int tid = otid(), lane = tid & 63, wave = __builtin_amdgcn_readfirstlane(tid >> 6);
    const float* PROJ = (const float*)(a.ws + WS_PROJ); float* SG = (float*)(a.ws + WS_SG);
    float* Xre = lds;
    float* Xim = lds + 64 * 65;
    float* Cre = lds + 2 * 64 * 65;
    float* Cim = Cre + 1024;
    float* U = Cim + 1024;
    for (int u = blockIdx.x; u < NB * 16; u += gridDim.x) {
        const int b = u / 16, g = u % 16;
        __syncthreads();
        for (int i = tid; i < 1024; i += NTHR) { Cre[i] = a.in[I_SCRE][((size_t)l * 16 + g) * 1024 + i]; Cim[i] = a.in[I_SCIM][((size_t)l * 16 + g) * 1024 + i]; }
        float are = 0.f, aim = 0.f, bbre[16], bbim[16], xre = 0.f, xim = 0.f;
        if (wave == 0) {
            const int p = lane; const float lre = a.in[I_SARE][(l * 16 + g) * 64 + p], lim = a.in[I_SAIM][(l * 16 + g) * 64 + p];
            const float dt = expf(a.in[I_SLDT][l * 16 + g]); const float mag = expf(lre * dt);
            are = mag * cosf(lim * dt); aim = mag * sinf(lim * dt);
            const float den = lre * lre + lim * lim;
            const float cre = ((are - 1.f) * lre + aim * lim) / den, cim = (aim * lre - (are - 1.f) * lim) / den;
#pragma unroll
            for (int h = 0; h < 16; ++h) { const float br = a.in[I_SBRE][(((size_t)l * 16 + g) * 64 + p) * 16 + h], bi = a.in[I_SBIM][(((size_t)l * 16 + g) * 64 + p) * 16 + h];
                bbre[h] = cre * br - cim * bi; bbim[h] = cre * bi + cim * br; }
        }
        for (int c = 0; c < SEQ / 64; ++c) {
            __syncthreads();
            for (int i = tid; i < 1024; i += NTHR) { const int tt = i >> 4, h = i & 15; U[i] = PROJ[(size_t)(b * SEQ + c * 64 + tt) * INW + OD_U + g * 16 + h]; }
            __syncthreads();
            if (wave == 0) {
                for (int tt = 0; tt < 64; ++tt) {
                    float bre = 0.f, bim = 0.f;
#pragma unroll
                    for (int h = 0; h < 16; ++h) { const float uu = U[tt * 16 + h]; bre = fmaf(uu, bbre[h], bre); bim = fmaf(uu, bbim[h], bim); }
                    const float nre = are * xre - aim * xim + bre, nim = are * xim + aim * xre + bim;
                    xre = nre; xim = nim; Xre[tt * 65 + lane] = xre; Xim[tt * 65 + lane] = xim;
                }
            }
            __syncthreads();
            for (int i = tid; i < 1024; i += NTHR) { const int tt = i >> 4, h = i & 15; float y = 0.f;
                for (int p = 0; p < 64; ++p) y += Xre[tt * 65 + p] * Cre[h * 64 + p] - Xim[tt * 65 + p] * Cim[h * 64 + p];
                y += a.in[I_SD][l * 256 + g * 16 + h] * U[i];
                SG[(size_t)(b * SEQ + c * 64 + tt) * 256 + g * 16 + h] = gelu_tanh(y); }
        }
    }
    __syncthreads();
}

template <int MODE>
__device__ __forceinline__ void ph_attn(const Args& a, float* lds) {
    const int tid_ = otid(); const int lane = tid_ & 63, wave = __builtin_amdgcn_readfirstlane(tid_ >> 6);
    const float* PROJ = (const float*)(a.ws + WS_PROJ);
    const float* MQ = (const float*)(a.ws + WS_MQ); const float* MKV = (const float*)(a.ws + WS_MKV); const float* KR = (const float*)(a.ws + WS_KR);
    const float* CUM = (const float*)(a.ws + WS_CUM);
    const unsigned long long* MASK = (const unsigned long long*)(a.ws + WS_MASK);
    const int* POS = (const int*)a.in[I_POS];
    float* GRP = (float*)(a.ws + WS_GRP);
    float* lg = lds + wave * (2048 + 128);
    float* qs = lg + 2048;
    constexpr int DK = (MODE == 1) ? 96 : 64;
    const float scale = (MODE == 1) ? 0.10206207261596577f : 0.125f;
    for (int u = blockIdx.x * NWAVES + wave; u < T * 4; u += gridDim.x * NWAVES) {
        const int r = u >> 2, h = u & 3, b = r / SEQ, t = r % SEQ;
        const float* qp = (MODE == 0) ? PROJ + (size_t)r * INW + OA_Q + h * 64 : (MODE == 1) ? MQ + (size_t)r * 384 + h * 96 : PROJ + (size_t)r * INW + OC_Q + h * 64;
        __builtin_amdgcn_wave_barrier();
        for (int i = lane; i < DK; i += 64) qs[i] = qp[i];
        __builtin_amdgcn_wave_barrier();
        const int nw = t / 64 + 1; float mx = -INFINITY;
        const int post = (MODE == 0) ? POS[r] : 0;
        const float cumt = (MODE == 2) ? CUM[(size_t)(b * 4 + h) * SEQ + t] : 0.f;
        for (int j = 0; j < nw; ++j) {
            const int s = j * 64 + lane; float lgt = -INFINITY; bool ok = s <= t;
            if (MODE == 0) { const unsigned long long m = MASK[(size_t)r * 32 + j]; ok = ok && ((m >> lane) & 1ull); }
            if (ok) {
                const size_t rs = (size_t)(b * SEQ + s); float d = 0.f;
                if (MODE == 1) {
                    const float* kn = MKV + rs * 512 + h * 128; const float* kr = KR + rs * 32;
#pragma unroll 4
                    for (int x = 0; x < 64; x += 4) { const float4 k = ld4(kn + x), q = ld4(qs + x); d = fmaf(q.x, k.x, d); d = fmaf(q.y, k.y, d); d = fmaf(q.z, k.z, d); d = fmaf(q.w, k.w, d); }
#pragma unroll 4
                    for (int x = 0; x < 32; x += 4) { const float4 k = ld4(kr + x), q = ld4(qs + 64 + x); d = fmaf(q.x, k.x, d); d = fmaf(q.y, k.y, d); d = fmaf(q.z, k.z, d); d = fmaf(q.w, k.w, d); }
                } else {
                    const float* kp = PROJ + rs * INW + ((MODE == 0) ? OA_K : OC_K) + h * 64;
#pragma unroll 4
                    for (int x = 0; x < 64; x += 4) { const float4 k = ld4(kp + x), q = ld4(qs + x); d = fmaf(q.x, k.x, d); d = fmaf(q.y, k.y, d); d = fmaf(q.z, k.z, d); d = fmaf(q.w, k.w, d); }
                }
                lgt = d * scale;
                if (MODE == 0) { int n = post - POS[rs]; n = n < 0 ? 0 : n; int bk;
                    if (n < 16) bk = n; else { const float nf = (float)n; const float lr = logf(nf / 16.f) / 2.0794415416798357f; int lgb = 16 + (int)(lr * 16.f); bk = lgb < 31 ? lgb : 31; }
                    lgt += a.in[I_RELB][bk * 4 + h]; }
                if (MODE == 2) lgt += cumt - CUM[(size_t)(b * 4 + h) * SEQ + s];
            }
            lg[s] = lgt; mx = fmaxf(mx, lgt);
        }
        mx = wave_max(mx); float sum = 0.f;
        for (int j = 0; j < nw; ++j) { const int s = j * 64 + lane; const float p = expf(lg[s] - mx); lg[s] = p; sum += p; }
        sum = wave_sum(sum);
        __builtin_amdgcn_wave_barrier();
        float o0 = 0.f, o1 = 0.f, o2 = 0.f, o3 = 0.f;
        const float* vb = (MODE == 0) ? PROJ + (size_t)(b * SEQ) * INW + OA_V + h * 64 + lane : (MODE == 1) ? MKV + (size_t)(b * SEQ) * 512 + h * 128 + 64 + lane : PROJ + (size_t)(b * SEQ) * INW + OC_V + h * 64 + lane;
        constexpr int VP = (MODE == 1) ? 512 : INW;
        if (MODE == 0) {
            for (int j = 0; j < nw; ++j) { unsigned long long m = MASK[(size_t)r * 32 + j];
                m = ((unsigned long long)__builtin_amdgcn_readfirstlane((unsigned)(m >> 32)) << 32) | (unsigned long long)__builtin_amdgcn_readfirstlane((unsigned)m);
                while (m) { const int bit = __builtin_ctzll(m); m &= m - 1; const int s = j * 64 + bit; if (s <= t) o0 = fmaf(lg[s], vb[(size_t)s * VP], o0); } }
        } else {
            int s = 0;
            for (; s + 3 <= t; s += 4) { o0 = fmaf(lg[s], vb[(size_t)s * VP], o0); o1 = fmaf(lg[s + 1], vb[(size_t)(s + 1) * VP], o1); o2 = fmaf(lg[s + 2], vb[(size_t)(s + 2) * VP], o2); o3 = fmaf(lg[s + 3], vb[(size_t)(s + 3) * VP], o3); }
            for (; s <= t; ++s) o0 = fmaf(lg[s], vb[(size_t)s * VP], o0);
        }
        GRP[(size_t)r * DM + MODE * 256 + h * 64 + lane] = (o0 + o1 + o2 + o3) / sum;
    }
}

__device__ __forceinline__ void ph_peer_topk(const Args& a, int l, float* lds) {
    const int tid_ = otid(); const int lane = tid_ & 63, wave = __builtin_amdgcn_readfirstlane(tid_ >> 6);
    const float* PQ = (const float*)(a.ws + WS_PROJ);
    int* PIDX = (int*)(a.ws + WS_PIDX); float* PGATE = (float*)(a.ws + WS_PGATE);
    const float* SK1 = a.in[I_SK1] + (size_t)l * 128 * 128; const float* SK2 = a.in[I_SK2] + (size_t)l * 128 * 128;
    float* qs = lds + wave * 320;
    float* tv = qs + 256;
    int* ti = (int*)(tv + 32);
    for (int u = blockIdx.x * NWAVES + wave; u < T * 8; u += gridDim.x * NWAVES) {
        const int r = u >> 3, h = u & 7;
        __builtin_amdgcn_wave_barrier();
        for (int i = lane; i < 256; i += 64) qs[i] = PQ[(size_t)r * 2048 + h * 256 + i];
        __builtin_amdgcn_wave_barrier();
        float sv[2][2];
#pragma unroll
        for (int c = 0; c < 2; ++c)
#pragma unroll
            for (int kk = 0; kk < 2; ++kk) { const float* kp = (c == 0 ? SK1 : SK2) + (size_t)(lane + 64 * kk) * 128; float d = 0.f;
#pragma unroll 4
                for (int x = 0; x < 128; x += 4) { const float4 k = ld4(kp + x), q = ld4(qs + c * 128 + x); d = fmaf(q.x, k.x, d); d = fmaf(q.y, k.y, d); d = fmaf(q.z, k.z, d); d = fmaf(q.w, k.w, d); }
                sv[c][kk] = d; }
#pragma unroll
        for (int c = 0; c < 2; ++c) {
            float v0 = sv[c][0], v1 = sv[c][1];
            for (int it = 0; it < 16; ++it) {
                float bv; int bi; if (v0 >= v1) { bv = v0; bi = lane; } else { bv = v1; bi = lane + 64; }
#pragma unroll
                for (int o = 32; o > 0; o >>= 1) { const float ov = __shfl_xor(bv, o); const int oi = __shfl_xor(bi, o); if (ov > bv || (ov == bv && oi < bi)) { bv = ov; bi = oi; } }
                if (lane == 0) { tv[c * 16 + it] = bv; ti[c * 16 + it] = bi; }
                if (bi == lane) v0 = -INFINITY; if (bi == lane + 64) v1 = -INFINITY;
            }
        }
        __builtin_amdgcn_wave_barrier();
        float cv[4];
#pragma unroll
        for (int q = 0; q < 4; ++q) { const int ic = lane + 64 * q; cv[q] = tv[ic >> 4] + tv[16 + (ic & 15)]; }
        float myv = 0.f; int mye = 0;
        for (int it = 0; it < 16; ++it) {
            float bv = cv[0]; int bi = lane;
#pragma unroll
            for (int q = 1; q < 4; ++q) if (cv[q] > bv) { bv = cv[q]; bi = lane + 64 * q; }
#pragma unroll
            for (int o = 32; o > 0; o >>= 1) { const float ov = __shfl_xor(bv, o); const int oi = __shfl_xor(bi, o); if (ov > bv || (ov == bv && oi < bi)) { bv = ov; bi = oi; } }
            if (lane == it) { myv = bv; mye = ti[bi >> 4] * 128 + ti[16 + (bi & 15)]; }
#pragma unroll
            for (int q = 0; q < 4; ++q) if (bi == lane + 64 * q) cv[q] = -INFINITY;
        }
        float mv = (lane < 16) ? myv : -INFINITY; mv = wave_max(mv);
        float e = (lane < 16) ? expf(myv - mv) : 0.f; const float se = wave_sum(e);
        if (lane < 16) { PIDX[(size_t)r * 128 + h * 16 + lane] = mye; PGATE[(size_t)r * 128 + h * 16 + lane] = e / se; }
    }
}

__device__ __forceinline__ void ph_peer_gather(const Args& a, int l) {
    const int tid_ = otid(); const int lane = tid_ & 63, wave = __builtin_amdgcn_readfirstlane(tid_ >> 6);
    const float* H = (const float*)(a.ws + WS_H); float* X = (float*)(a.ws + WS_X);
    const int* PIDX = (const int*)(a.ws + WS_PIDX); const float* PGATE = (const float*)(a.ws + WS_PGATE);
    const float* PU = a.in[I_PU] + (size_t)l * 16384 * DM; const float* PV = a.in[I_PV] + (size_t)l * 16384 * DM;
    const float* MOD = (const float*)(a.ws + WS_MOD) + (size_t)l * 8 * 6144;
    for (int r = blockIdx.x * NWAVES + wave; r < T; r += gridDim.x * NWAVES) {
        float4 hv[4], y[4];
#pragma unroll
        for (int j = 0; j < 4; ++j) { hv[j] = ld4(H + (size_t)r * DM + lane * 4 + 256 * j); y[j] = make_float4(0.f, 0.f, 0.f, 0.f); }
        for (int e0 = 0; e0 < 128; e0 += 2) {
            const int ea = PIDX[(size_t)r * 128 + e0], eb = PIDX[(size_t)r * 128 + e0 + 1];
            const float ga = PGATE[(size_t)r * 128 + e0], gb = PGATE[(size_t)r * 128 + e0 + 1];
            float da = 0.f, db = 0.f;
#pragma unroll
            for (int j = 0; j < 4; ++j) { const float4 ua = ld4(PU + (size_t)ea * DM + lane * 4 + 256 * j), ub = ld4(PU + (size_t)eb * DM + lane * 4 + 256 * j);
                da += hv[j].x * ua.x + hv[j].y * ua.y + hv[j].z * ua.z + hv[j].w * ua.w; db += hv[j].x * ub.x + hv[j].y * ub.y + hv[j].z * ub.z + hv[j].w * ub.w; }
            da = wave_sum(da); db = wave_sum(db);
            const float wa = ga * gelu_tanh(da), wb = gb * gelu_tanh(db);
#pragma unroll
            for (int j = 0; j < 4; ++j) { const float4 va = ld4(PV + (size_t)ea * DM + lane * 4 + 256 * j), vb = ld4(PV + (size_t)eb * DM + lane * 4 + 256 * j);
                y[j].x += wa * va.x + wb * vb.x; y[j].y += wa * va.y + wb * vb.y; y[j].z += wa * va.z + wb * vb.z; y[j].w += wa * va.w + wb * vb.w; }
        }
        const int b = r / SEQ;
#pragma unroll
        for (int j = 0; j < 4; ++j) { const int c = lane * 4 + 256 * j; const float4 g = ld4(MOD + (size_t)b * 6144 + 5120 + c); float4 x = ld4(X + (size_t)r * DM + c);
            x.x += g.x * y[j].x; x.y += g.y * y[j].y; x.z += g.z * y[j].z; x.w += g.w * y[j].w; st4(X + (size_t)r * DM + c, x); }
    }
}

#ifndef EN_S5
#define EN_S5 1
#endif
#ifndef EN_DSA
#define EN_DSA 1
#endif
#ifndef EN_ATT
#define EN_ATT 7
#endif
#ifndef EN_PTK
#define EN_PTK 1
#endif
#ifndef EN_PG
#define EN_PG 1
#endif
#ifndef EN_GEMM
#define EN_GEMM 1
#endif
constexpr int PH_PER_LAYER = 12, N_PHASES = 1 + DEPTH * PH_PER_LAYER + 1;
__global__ void __launch_bounds__(NTHR, 2) fwd(Args a) {
    extern __shared__ __attribute__((aligned(16))) unsigned char lds_raw[];
    float* lds = (float*)lds_raw;
    volatile LAS unsigned* stw = (volatile LAS unsigned*)(LAS unsigned char*)(lds_raw + LDS_BYTES - 16);
    if (threadIdx.x == 0) { stw[0] = 0u; stw[1] = 0u; }
    __syncthreads();
    XcdBarrier bar; bar.bar = (unsigned*)(a.ws + WS_CTL) + 4096; bar.x = 0; bar.st = stw;
    const int lo = a.ph_lo, hi = a.ph_hi;
    if (hi - lo > 1) bar = xcd_barrier_post((unsigned*)(a.ws + WS_CTL) + 4096, stw);
#define IN(k) (lo <= (k) && (k) < hi)
#define SEAM(k) do { if (IN(k) && IN((k) + 1)) xcd_barrier(bar); } while (0)
    float* MOD = (float*)(a.ws + WS_MOD); float* H = (float*)(a.ws + WS_H); float* PROJ = (float*)(a.ws + WS_PROJ);
    float* XC = (float*)(a.ws + WS_X); float* GRP = (float*)(a.ws + WS_GRP);
    float* QN = (float*)(a.ws + WS_QN); float* KVN = (float*)(a.ws + WS_KVN); float* MQ = (float*)(a.ws + WS_MQ); float* MKV = (float*)(a.ws + WS_MKV);
    float* KR = (float*)(a.ws + WS_KR); float* SG = (float*)(a.ws + WS_SG); float* SZ = (float*)(a.ws + WS_SZ);
    const int* POS = (const int*)a.in[I_POS];

    if (IN(0)) { ph_mod(a, lds); } SEAM(0);
    for (int l = 0; l < DEPTH; ++l) {
        const int p0 = 1 + l * PH_PER_LAYER;
        const float* Xin = (l == 0) ? a.in[I_X] : XC;
        const float* modl = MOD + (size_t)l * 8 * 6144;
        if (IN(p0 + 0)) ph_modnorm(a, Xin, a.in[I_N1G] + l * DM, modl + 0, modl + 1024, H);
        SEAM(p0 + 0);
        if (IN(p0 + 1)) { EpiStore e{PROJ, INW}; gemm_f32(H, DM, a.in[I_WIN] + (size_t)l * DM * INW, INW, T, INW, DM, lds, e); }
        SEAM(p0 + 1);
        if (IN(p0 + 2)) {
            if (EN_S5) ph_s5(a, l, lds);
            if (EN_DSA) ph_dsa_mask(a, lds);
            rows_rmsnorm<256>(PROJ + OB_CQ, INW, a.in[I_MQG] + l * 256, QN);
            rows_rmsnorm<128>(PROJ + OB_CKV, INW, a.in[I_MKVG] + l * 128, KVN);
            const int tid = otid();
            for (int i = blockIdx.x * NTHR + tid; i < T * 16; i += gridDim.x * NTHR) { const int r = i >> 4, d = i & 15; float o1, o2;
                rope_pair(PROJ[(size_t)r * INW + OB_KR + d], PROJ[(size_t)r * INW + OB_KR + 16 + d], POS[r], d, o1, o2); KR[(size_t)r * 32 + d] = o1; KR[(size_t)r * 32 + 16 + d] = o2; }
            ph_fox_cum(a, l);
        }
        SEAM(p0 + 2);
        if (IN(p0 + 3)) {
            { EpiStore e{MQ, 384}; gemm_f32(QN, 256, a.in[I_WUQ] + (size_t)l * 256 * 384, 384, T, 384, 256, lds, e); }
            { EpiStore e{MKV, 512}; gemm_f32(KVN, 128, a.in[I_WUKV] + (size_t)l * 128 * 512, 512, T, 512, 128, lds, e); }
            { EpiStore e{SZ, 256}; gemm_f32(SG, 256, a.in[I_SWGLU] + (size_t)l * 256 * 256, 256, T, 256, 256, lds, e); }
        }
        SEAM(p0 + 3);
        if (IN(p0 + 4)) {
            const int tid = otid();
            for (int i = blockIdx.x * NTHR + tid; i < T * 64; i += gridDim.x * NTHR) { const int r = i >> 6, h = (i >> 4) & 3, d = i & 15; float o1, o2;
                float* q = MQ + (size_t)r * 384 + h * 96 + 64; rope_pair(q[d], q[16 + d], POS[r], d, o1, o2); q[d] = o1; q[16 + d] = o2; }
            for (int i = blockIdx.x * NTHR + tid; i < T * 256; i += gridDim.x * NTHR) { const int r = i >> 8, c = i & 255; const float g = SG[i];
                GRP[(size_t)r * DM + 768 + c] = g * sigmoidf_(SZ[i] + a.in[I_SBGLU][l * 256 + c]); }
        }
        SEAM(p0 + 4);
        if (IN(p0 + 5)) { if (EN_ATT & 1) ph_attn<0>(a, lds); if (EN_ATT & 2) ph_attn<1>(a, lds); if (EN_ATT & 4) ph_attn<2>(a, lds); }
        SEAM(p0 + 5);
        if (IN(p0 + 6)) {
            const int tid = otid(), lane = tid & 63, wave = __builtin_amdgcn_readfirstlane(tid >> 6);
            for (int u = blockIdx.x * NWAVES + wave; u < T * 4; u += gridDim.x * NWAVES) { const int r = u >> 2, g = u & 3; float* p = GRP + (size_t)r * DM + g * 256 + lane * 4;
                float4 v = ld4(p); const float rs = rsqrtf(wave_sum(v.x * v.x + v.y * v.y + v.z * v.z + v.w * v.w) * (1.f / 256.f) + EPS);
                const float4 gg = ld4(a.in[I_GNG] + l * DM + g * 256 + lane * 4); st4(p, make_float4(v.x * rs * gg.x, v.y * rs * gg.y, v.z * rs * gg.z, v.w * rs * gg.w)); }
        }
        SEAM(p0 + 6);
        if (IN(p0 + 7)) { EpiResGate e{Xin, XC, modl + 2048}; gemm_f32(GRP, DM, a.in[I_WOUT] + (size_t)l * DM * DM, DM, T, DM, DM, lds, e); }
        SEAM(p0 + 7);
        if (IN(p0 + 8)) ph_modnorm(a, XC, a.in[I_N2G] + l * DM, modl + 3072, modl + 4096, H);
        SEAM(p0 + 8);
        if (IN(p0 + 9)) { EpiStore e{PROJ, 2048}; gemm_f32(H, DM, a.in[I_PWQ] + (size_t)l * DM * 2048, 2048, T, 2048, DM, lds, e); }
        SEAM(p0 + 9);
        if (IN(p0 + 10) && EN_PTK) ph_peer_topk(a, l, lds);
        SEAM(p0 + 10);
        if (IN(p0 + 11) && EN_PG) ph_peer_gather(a, l);
        SEAM(p0 + 11);
    }
    if (IN(N_PHASES - 1)) {
        const int tid = otid(), lane = tid & 63, wave = __builtin_amdgcn_readfirstlane(tid >> 6);
        for (int r = blockIdx.x * NWAVES + wave; r < T; r += gridDim.x * NWAVES) { float4 v[4]; float s = 0.f;
#pragma unroll
            for (int j = 0; j < 4; ++j) { v[j] = ld4(XC + (size_t)r * DM + lane * 4 + 256 * j); s += v[j].x * v[j].x + v[j].y * v[j].y + v[j].z * v[j].z + v[j].w * v[j].w; }
            const float rs = rsqrtf(wave_sum(s) * (1.f / DM) + EPS);
#pragma unroll
            for (int j = 0; j < 4; ++j) { const int c = lane * 4 + 256 * j; const float4 g = ld4(a.in[I_FING] + c); st4(a.out + (size_t)r * DM + c, make_float4(v[j].x * rs * g.x, v[j].y * rs * g.y, v[j].z * rs * g.z, v[j].w * rs * g.w)); }
        }
    }
}

extern "C" void kernel_launch(void* const* d_in, const int* in_sizes, int n_in, void* d_out, int out_size, void* d_ws, size_t ws_size, hipStream_t stream) {
    static int grid = 0;
    if (grid == 0) {
        if (n_in != 32 || out_size != T * DM || ws_size < WS_END) { fprintf(stderr, "kernel_launch: unexpected shapes (n_in %d out %d ws %zu)\n", n_in, out_size, ws_size); grid = -1; return; }
        int dev = 0, cus = 0;
        if (hipGetDevice(&dev) != hipSuccess || hipDeviceGetAttribute(&cus, hipDeviceAttributeMultiprocessorCount, dev) != hipSuccess) { grid = -1; return; }
        if (hipFuncSetAttribute((const void*)fwd, hipFuncAttributeMaxDynamicSharedMemorySize, LDS_BYTES) != hipSuccess) { fprintf(stderr, "kernel_launch: hipFuncSetAttribute failed\n"); grid = -1; return; }
        int per_cu = 0;
        if (hipOccupancyMaxActiveBlocksPerMultiprocessor(&per_cu, (const void*)fwd, NTHR, LDS_BYTES) != hipSuccess || per_cu < 1) { fprintf(stderr, "kernel_launch: occupancy query says %d\n", per_cu); }
        (void)hipGetLastError();
        grid = cus;
    }
    if (grid < 0) return;
    (void)hipMemsetAsync((char*)d_ws + WS_CTL, 0, CTL_ZERO_BYTES, stream);
    Args a{};
    for (int i = 0; i < 32; ++i) a.in[i] = (const float*)d_in[i];
    a.out = (float*)d_out; a.ws = (unsigned char*)d_ws;
#if MK_MULTI
    for (int p = 0; p < N_PHASES; ++p) { a.ph_lo = p; a.ph_hi = p + 1; hipLaunchKernelGGL(fwd, dim3(grid), dim3(NTHR), LDS_BYTES, stream, a); }
#else
    a.ph_lo = 0; a.ph_hi = N_PHASES; hipLaunchKernelGGL(fwd, dim3(grid), dim3(NTHR), LDS_BYTES, stream, a);
#endif
}
```

```cpp
#include <hip/hip_runtime.h>
#include <cstdio>
#include <cstdint>

#ifndef DUP
#define DUP -1
#endif
#define REPS(k) for (int rep_ = 0; rep_ < ((DUP == (k)) ? 2 : 1); ++rep_)
#ifndef MK_MULTI
#define MK_MULTI 0
#ifndef PA_SETS
#define PA_SETS 2
#endif
#endif

constexpr int DM = 1024, NB = 8, SEQ = 2048, T = NB * SEQ, DEPTH = 2;
constexpr int INW = 2536;
constexpr int NTHR = 512, NWAVES = 8;
constexpr int LDS_BYTES = 147456;
constexpr float EPS = 1e-6f;

constexpr size_t MiB = 1u << 20;
constexpr size_t WS_CTL = 0, CTL_ZERO_BYTES = 1 * MiB;
constexpr size_t WS_MOD = 1 * MiB;
constexpr size_t WS_WIN = 2 * MiB;
constexpr size_t WS_WOUT = 12 * MiB;
constexpr size_t WS_WPQ = 16 * MiB;
constexpr size_t WS_WUQ = 24 * MiB;
constexpr size_t WS_WUKV = 24 * MiB + 512 * 1024;
constexpr size_t WS_WGLU = 25 * MiB;
constexpr size_t WS_SKB = 25 * MiB + 512 * 1024;
constexpr size_t WS_ROPE = 26 * MiB;
constexpr size_t WS_HB = 28 * MiB;
constexpr size_t WS_PBF = 60 * MiB;
constexpr size_t WS_PF32 = 118 * MiB;
constexpr size_t WS_PQ = 60 * MiB;
constexpr size_t WS_KVB = 162 * MiB;
constexpr size_t WS_KRB = 178 * MiB;
constexpr size_t WS_MASK = 186 * MiB;
constexpr size_t WS_PW = 190 * MiB;
constexpr size_t WS_QN = 190 * MiB;
constexpr size_t WS_KVN = 198 * MiB;
constexpr size_t WS_QB = 206 * MiB;
constexpr size_t WS_CUM = 230 * MiB;
constexpr size_t WS_GRP = 231 * MiB;
constexpr size_t WS_GN = 295 * MiB;
constexpr size_t WS_SG = 327 * MiB;
constexpr size_t WS_SGB = 343 * MiB;
constexpr size_t WS_X = 351 * MiB;
constexpr size_t WS_PIDX = 415 * MiB;
constexpr size_t WS_PGATE = 423 * MiB;
constexpr size_t WS_SZ = 431 * MiB;
constexpr size_t WS_S5E = 180 * MiB;
constexpr size_t WS_U8 = 447 * MiB;
constexpr size_t WS_V8 = 479 * MiB;
constexpr size_t WS_SU = 511 * MiB;
constexpr size_t WS_SV = 511 * MiB + 128 * 1024;
constexpr size_t WS_END = 511 * MiB + 256 * 1024;

#define XB_TMO      128
#define XB_XCNT(j)  (256  + 64 * (j))
#define XB_XSUB(j)  (1280 + 64 * (j))
#define XB_XGEN(j)  (2304 + 64 * (j))
#define XB_TOP      3328
#define XB_TOPGEN   3392
#define XCD_BAR_WORDS 3456
#define XB_SPIN_CAP (1u << 18)
#define LAS __attribute__((address_space(3)))

__device__ __forceinline__ unsigned xb_ld(unsigned* p)              { return __hip_atomic_load(p, __ATOMIC_RELAXED, __HIP_MEMORY_SCOPE_AGENT); }
__device__ __forceinline__ unsigned xb_add(unsigned* p, unsigned v) { return __hip_atomic_fetch_add(p, v, __ATOMIC_RELAXED, __HIP_MEMORY_SCOPE_AGENT); }
__device__ __forceinline__ unsigned xb_xcc_id() { return (unsigned)__builtin_amdgcn_s_getreg((3 << 11) | 20) & 0xFu; }
#define XB_SPIN(cond, bar) do { unsigned _sp = 0; while (cond) { __builtin_amdgcn_s_sleep(1); \
    if ((++_sp & 255u) == 0u) { if (xb_ld(&(bar)[XB_TMO])) break; if (_sp > XB_SPIN_CAP) { atomicAdd(&(bar)[XB_TMO], 1u); break; } } } } while (0)

struct XcdBarrier { unsigned* bar; unsigned x; volatile LAS unsigned* st; };

__device__ __forceinline__ XcdBarrier xcd_barrier_post(unsigned* bar, volatile LAS unsigned* st) {
    XcdBarrier b; b.bar = bar; b.x = xb_xcc_id(); b.st = st;
    if (threadIdx.x == 0) (void)xb_add(&bar[XB_XCNT(b.x)], 1u);
    return b;
}
__device__ __forceinline__ void xcd_barrier_complete(unsigned* bar, unsigned x, unsigned& nloc, unsigned& nx) {
    const unsigned G = gridDim.x * gridDim.y * gridDim.z;
    unsigned sum, cnt, mine, sp = 0u;
    for (;;) {
        sum = 0u; cnt = 0u; mine = 0u;
#pragma unroll 1
        for (unsigned j = 0; j < 16; ++j) { const unsigned c = xb_ld(&bar[XB_XCNT(j)]); sum += c; cnt += (c > 0u) ? 1u : 0u; mine = (j == x) ? c : mine; }
        if (sum == G) break;
        __builtin_amdgcn_s_sleep(1);
        if ((++sp & 255u) == 0u) { if (xb_ld(&bar[XB_TMO])) break; if (sp > XB_SPIN_CAP) { atomicAdd(&bar[XB_TMO], 1u); break; } }
    }
    nloc = mine > 0u ? mine : 1u; nx = cnt > 0u ? cnt : 1u;
}
__device__ __forceinline__ void xcd_barrier(const XcdBarrier& b) {
    asm volatile("s_waitcnt vmcnt(0)" ::: "memory");
    __syncthreads();
    if (threadIdx.x == 0) {
        unsigned* bar = b.bar;
        __builtin_amdgcn_s_waitcnt(0);
        unsigned nloc = b.st[0], nx = b.st[1];
        if (nloc == 0u) { xcd_barrier_complete(bar, b.x, nloc, nx); b.st[0] = nloc; b.st[1] = nx; }
        const unsigned old = xb_add(&bar[XB_XSUB(b.x)], 1u);
        const unsigned gen = old / nloc;
        if (old + 1u == (gen + 1u) * nloc) {
            __builtin_amdgcn_fence(__ATOMIC_RELEASE, "agent");
            asm volatile("s_waitcnt vmcnt(0)" ::: "memory");
            const unsigned og = xb_add(&bar[XB_TOP], 1u);
            const unsigned tg = og / nx;
            if (og + 1u == (tg + 1u) * nx) xb_add(&bar[XB_TOPGEN], 1u);
            else XB_SPIN(xb_ld(&bar[XB_TOPGEN]) == tg, bar);
            __builtin_amdgcn_fence(__ATOMIC_ACQUIRE, "agent");
            xb_add(&bar[XB_XGEN(b.x)], 1u);
            asm volatile("s_waitcnt vmcnt(0)" ::: "memory");
        } else {
            XB_SPIN(xb_ld(&bar[XB_XGEN(b.x)]) == gen, bar);
            __builtin_amdgcn_fence(__ATOMIC_ACQUIRE, "agent");
            asm volatile("s_waitcnt vmcnt(0)" ::: "memory");
        }
    }
    __syncthreads();
}

struct Args { const float* in[32]; float* out; unsigned char* ws; int ph_lo, ph_hi; };
extern __shared__ __attribute__((aligned(16))) unsigned char lds_raw[];
constexpr int PTAB_OFF = LDS_BYTES - 1024;
__device__ __forceinline__ unsigned long long ptab_get(int i) { asm volatile("" : "+s"(i));
    const LAS unsigned* p = (const LAS unsigned*)((LAS unsigned char*)lds_raw + PTAB_OFF + 8 * i); const unsigned vx = p[0], vy = p[1];
    return ((unsigned long long)(unsigned)__builtin_amdgcn_readfirstlane((int)vy) << 32) | (unsigned)__builtin_amdgcn_readfirstlane((int)vx); }
#define GAS __attribute__((address_space(1)))
__device__ __forceinline__ const float* inp(int i) { return (const float*)(const GAS float*)ptab_get(i); }
__device__ __forceinline__ unsigned char* wsp() { return (unsigned char*)(GAS unsigned char*)ptab_get(32); }
__device__ __forceinline__ float* outp() { return (float*)(GAS float*)ptab_get(33); }
enum { I_X = 0, I_C, I_POS, I_RELB, I_ADAW, I_ADAB, I_N1G, I_WIN, I_MQG, I_MKVG, I_WUQ, I_WUKV, I_FOXB, I_SARE, I_SAIM, I_SLDT,
       I_SBRE, I_SBIM, I_SCRE, I_SCIM, I_SD, I_SWGLU, I_SBGLU, I_GNG, I_WOUT, I_N2G, I_PWQ, I_SK1, I_SK2, I_PU, I_PV, I_FING };

__device__ __forceinline__ int obx() { int v = blockIdx.x; asm volatile("" : "+s"(v)); return v; }
__device__ __forceinline__ int ogx() { int v = gridDim.x; asm volatile("" : "+s"(v)); return v; }
__device__ __forceinline__ int otid(int wv) { asm volatile("" : "+s"(wv)); unsigned z = 0u; asm volatile("" : "+v"(z)); int t = (wv << 6) | (int)__builtin_amdgcn_mbcnt_hi(~0u, __builtin_amdgcn_mbcnt_lo(~0u, z)); asm volatile("" : "+v"(t)); return t; }
template <int K> __device__ __forceinline__ float swz(float v) { return __builtin_bit_cast(float, __builtin_amdgcn_ds_swizzle(__builtin_bit_cast(int, v), (K << 10) | 0x1F)); }
template <int K> __device__ __forceinline__ int swzi(int v) { return __builtin_amdgcn_ds_swizzle(v, (K << 10) | 0x1F); }
__device__ __forceinline__ float rdl(float v, int l) { return __builtin_bit_cast(float, __builtin_amdgcn_readlane(__builtin_bit_cast(int, v), l)); }
__device__ __forceinline__ float wave_sum(float v) { v += swz<1>(v); v += swz<2>(v); v += swz<4>(v); v += swz<8>(v); v += swz<16>(v); return rdl(v, 0) + rdl(v, 32); }
__device__ __forceinline__ float wave_max(float v) { v = fmaxf(v, swz<1>(v)); v = fmaxf(v, swz<2>(v)); v = fmaxf(v, swz<4>(v)); v = fmaxf(v, swz<8>(v)); v = fmaxf(v, swz<16>(v)); return fmaxf(rdl(v, 0), rdl(v, 32)); }
__device__ __forceinline__ float bperm(float v, int srclane) { return __builtin_bit_cast(float, __builtin_amdgcn_ds_bpermute(srclane << 2, __builtin_bit_cast(int, v))); }
__device__ __forceinline__ float gelu_tanh(float x) { return 0.5f * x * (1.f + tanhf(0.7978845608028654f * (x + 0.044715f * x * x * x))); }
__device__ __forceinline__ float sigmoidf_(float x) { return 1.f / (1.f + expf(-x)); }
typedef unsigned short bf16_t;
typedef unsigned v4u __attribute__((ext_vector_type(4)));
typedef unsigned v2u __attribute__((ext_vector_type(2)));
typedef unsigned v3u __attribute__((ext_vector_type(3), aligned(4)));
typedef float v4f __attribute__((ext_vector_type(4)));
typedef float v2f __attribute__((ext_vector_type(2)));
__device__ __forceinline__ unsigned f2bf(float f) { unsigned u = __builtin_bit_cast(unsigned, f); return (u + 0x7fffu + ((u >> 16) & 1u)) >> 16; }
__device__ __forceinline__ unsigned pk2(float lo, float hi) { return f2bf(lo) | (f2bf(hi) << 16); }
__device__ __forceinline__ float bf_lo(unsigned w) { return __builtin_bit_cast(float, w << 16); }
__device__ __forceinline__ float bf_hi(unsigned w) { return __builtin_bit_cast(float, w & 0xffff0000u); }
__device__ __forceinline__ float bf2f(bf16_t h) { return __builtin_bit_cast(float, (unsigned)h << 16); }
#define GAS __attribute__((address_space(1)))
__device__ __forceinline__ v4u ldg16(const void* p) { return *(const GAS v4u*)(unsigned long long)p; }
#define SCHED_FENCE() __builtin_amdgcn_sched_barrier(0)
__device__ __forceinline__ float4 ld4(const float* p) { return *(const float4*)p; }
__device__ __forceinline__ void st4(float* p, float4 v) { *(float4*)p = v; }

namespace pg8 {
#define PG8_LAS __attribute__((address_space(3)))
typedef unsigned short bf16_t;
typedef short bf16x8 __attribute__((ext_vector_type(8)));
typedef float f32x4 __attribute__((ext_vector_type(4)));
typedef unsigned u32x4 __attribute__((ext_vector_type(4)));
constexpr int BM = 256, BK = 64, HALF = 128, HTB = HALF * BK * 2  , STAGE_BYTES = 8 * HTB, NXCD = 8, WGM = 8;

__host__ __device__ __forceinline__ int lds_byte(int r, int c) { const int st = (r >> 4) * 2 + (c >> 5), rr = r & 15, cc = c & 31, ob = rr * 64 + cc * 2; return st * 1024 + (ob ^ (((ob >> 9) & 1) << 5)); }
__host__ __device__ __forceinline__ void stage_rc(int b, int& R, int& C) { const int st = b / 1024, sb = b % 1024, swz = sb ^ (((sb >> 9) & 1) << 5); R = (st >> 1) * 16 + swz / 64; C = (st & 1) * 32 + (swz % 64) / 2; }
__host__ __device__ __forceinline__ int perm32(int rho) { const int n = rho >> 4, i = rho & 15; return 8 * (i >> 2) + 4 * n + (i & 3); }

struct Unit { int pm, pn; };
struct Gemm { const bf16_t* A; const bf16_t* Bt; int M, N, K; };

struct StaticOrder {
    int nM, nN, nwg, G, c;
    __host__ __device__ void init(int M, int N, int G_, int c_) { nM = M / BM; nN = N / BM; nwg = nM * nN; G = G_; c = c_; }
    __host__ __device__ bool next(int i, Unit& u) const {
        const long L = (long)i * G + c; if (L >= nwg) return false;
        int wgid = (int)L; { const int q = nwg / NXCD, r = nwg % NXCD, xcd = wgid % NXCD, off = wgid / NXCD; wgid = (xcd < r ? xcd * (q + 1) : r * (q + 1) + (xcd - r) * q) + off; }
        const int nig = WGM * nN, gid = wgid / nig, fm = gid * WGM, gsz = (nM - fm) < WGM ? (nM - fm) : WGM;
        u.pm = fm + ((wgid % nig) % gsz); u.pn = (wgid % nig) / gsz; return true;
    }
    __device__ __forceinline__ void a_ready(const Unit&) const {}
    __device__ __forceinline__ void done(const Unit&) const {}
};
__device__ __forceinline__ unsigned cvt_pk_bf16(float lo, float hi) { unsigned r; asm volatile("v_cvt_pk_bf16_f32 %0, %1, %2" : "=v"(r) : "v"(lo), "v"(hi)); return r; }
typedef float f32x2 __attribute__((ext_vector_type(2)));

template <int ldc, int ncols> struct EpiF32 {
    static constexpr bool PERM = true, AFTER_DRAIN = false;
    float* C;
    __device__ __forceinline__ void operator()(const f32x4 (&acc)[2][2][4][2], const Unit& u, int wr, int wc, int fr, int fq) const {
        const int row0 = u.pm * BM + wr * 64 + fr, col0 = u.pn * BM + wc * 32 + 8 * fq;
#pragma unroll
        for (int ai = 0; ai < 2; ++ai)
#pragma unroll
            for (int m = 0; m < 4; ++m) { const unsigned ro = (unsigned)(row0 + ai * HALF + m * 16) * (unsigned)ldc;
#pragma unroll
                for (int bj = 0; bj < 2; ++bj) { const int c = col0 + bj * HALF; if (c < ncols) { *(f32x4*)(C + (ro + (unsigned)c)) = acc[ai][bj][m][0]; *(f32x4*)(C + (ro + (unsigned)c + 4u)) = acc[ai][bj][m][1]; } } }
    }
};
template <bool XBF> struct EpiResGate {
    static constexpr bool PERM = true, AFTER_DRAIN = false;
    const void* Xin; bf16_t* Xout; const float* gate;
    __device__ __forceinline__ void operator()(const f32x4 (&acc)[2][2][4][2], const Unit& u, int wr, int wc, int fr, int fq) const {
        const int row0 = u.pm * BM + wr * 64 + fr, col0 = u.pn * BM + wc * 32 + 8 * fq;
        const float* gp = gate + (size_t)((u.pm * BM) / 2048) * 6144;
#pragma unroll
        for (int bj = 0; bj < 2; ++bj) { const int c = col0 + bj * HALF; const f32x4 g0 = *(const f32x4*)(gp + c), g1 = *(const f32x4*)(gp + c + 4);
#pragma unroll
            for (int ai = 0; ai < 2; ++ai)
#pragma unroll
                for (int m = 0; m < 4; ++m) { const unsigned o = (unsigned)(row0 + ai * HALF + m * 16) * 1024u + (unsigned)c; f32x4 x0, x1;
                    if constexpr (XBF) { const u32x4 xb = *(const u32x4*)((const bf16_t*)Xin + o); x0 = (f32x4){bf_lo(xb.x), bf_hi(xb.x), bf_lo(xb.y), bf_hi(xb.y)}; x1 = (f32x4){bf_lo(xb.z), bf_hi(xb.z), bf_lo(xb.w), bf_hi(xb.w)}; }
                    else { x0 = *(const f32x4*)((const float*)Xin + o); x1 = *(const f32x4*)((const float*)Xin + o + 4); }
                    x0 = x0 + g0 * acc[ai][bj][m][0]; x1 = x1 + g1 * acc[ai][bj][m][1]; u32x4 w;
                    w.x = cvt_pk_bf16(x0[0], x0[1]); w.y = cvt_pk_bf16(x0[2], x0[3]); w.z = cvt_pk_bf16(x1[0], x1[1]); w.w = cvt_pk_bf16(x1[2], x1[3]); *(u32x4*)(Xout + o) = w; } }
    }
};
struct EpiBf16 {
    static constexpr bool PERM = true, AFTER_DRAIN = false;
    bf16_t* O; int ldc;
    __device__ __forceinline__ void operator()(const f32x4 (&acc)[2][2][4][2], const Unit& u, int wr, int wc, int fr, int fq) const {
        const int row0 = u.pm * BM + wr * 64 + fr, col0 = u.pn * BM + wc * 32 + 8 * fq;
#pragma unroll
        for (int ai = 0; ai < 2; ++ai)
#pragma unroll
            for (int m = 0; m < 4; ++m) { bf16_t* rowp = O + ((unsigned)(row0 + ai * HALF + m * 16) * (unsigned)ldc + (unsigned)col0);
#pragma unroll
                for (int bj = 0; bj < 2; ++bj) { const f32x4 v0 = acc[ai][bj][m][0], v1 = acc[ai][bj][m][1]; u32x4 w;
                    w.x = cvt_pk_bf16(v0[0], v0[1]); w.y = cvt_pk_bf16(v0[2], v0[3]); w.z = cvt_pk_bf16(v1[0], v1[1]); w.w = cvt_pk_bf16(v1[2], v1[3]);
                    *(u32x4*)(rowp + bj * HALF) = w; } }
    }
};
struct EpiProj {
    static constexpr bool PERM = true, AFTER_DRAIN = false;
    bf16_t* PBF; float* PF32;
    __device__ __forceinline__ void operator()(const f32x4 (&acc)[2][2][4][2], const Unit& u, int wr, int wc, int fr, int fq) const {
        const int row0 = u.pm * BM + wr * 64 + fr;
#pragma unroll
        for (int bj = 0; bj < 2; ++bj) {
            const int cb = u.pn * BM + bj * HALF + wc * 32, c = cb + 8 * fq;
            if (cb < 1856) {
#pragma unroll
                for (int ai = 0; ai < 2; ++ai)
#pragma unroll
                    for (int m = 0; m < 4; ++m) { const unsigned o = (unsigned)(row0 + ai * HALF + m * 16) * 1856u + (unsigned)c; const f32x4 v0 = acc[ai][bj][m][0], v1 = acc[ai][bj][m][1]; u32x4 w;
                        w.x = cvt_pk_bf16(v0[0], v0[1]); w.y = cvt_pk_bf16(v0[2], v0[3]); w.z = cvt_pk_bf16(v1[0], v1[1]); w.w = cvt_pk_bf16(v1[2], v1[3]); *(u32x4*)(PBF + o) = w; }
            } else if (c < 2536) {
#pragma unroll
                for (int ai = 0; ai < 2; ++ai)
#pragma unroll
                    for (int m = 0; m < 4; ++m) { const unsigned o = (unsigned)(row0 + ai * HALF + m * 16) * 704u + (unsigned)(c - 1856);
                        *(f32x4*)(PF32 + o) = acc[ai][bj][m][0]; *(f32x4*)(PF32 + o + 4u) = acc[ai][bj][m][1]; }
            }
        }
    }
};
template <int ldc, int ncols> struct EpiBf16N {
    static constexpr bool PERM = true, AFTER_DRAIN = false;
    bf16_t* O;
    __device__ __forceinline__ void operator()(const f32x4 (&acc)[2][2][4][2], const Unit& u, int wr, int wc, int fr, int fq) const {
        const int row0 = u.pm * BM + wr * 64 + fr, col0 = u.pn * BM + wc * 32 + 8 * fq;
#pragma unroll
        for (int bj = 0; bj < 2; ++bj) { const int c = col0 + bj * HALF; if (c >= ncols) continue;
#pragma unroll
            for (int ai = 0; ai < 2; ++ai)
#pragma unroll
                for (int m = 0; m < 4; ++m) { const unsigned o = (unsigned)(row0 + ai * HALF + m * 16) * (unsigned)ldc + (unsigned)c; const f32x4 v0 = acc[ai][bj][m][0], v1 = acc[ai][bj][m][1]; u32x4 w;
                    w.x = cvt_pk_bf16(v0[0], v0[1]); w.y = cvt_pk_bf16(v0[2], v0[3]); w.z = cvt_pk_bf16(v1[0], v1[1]); w.w = cvt_pk_bf16(v1[2], v1[3]); *(u32x4*)(O + o) = w; } }
    }
};
template <class Epi, class Sched, bool ALIGN_EPI = false, bool SP2 = false>
__device__ __forceinline__ void gemm_phase(PG8_LAS unsigned char* lds, const Gemm g, const Sched& S, const Epi& E, const int tid) {
    const int wid = __builtin_amdgcn_readfirstlane(tid >> 6), lane = tid & 63, wr = wid >> 2, wc = wid & 3, fr = lane & 15, fq = lane >> 4;
    const int K = g.K, nt = K / BK;
    unsigned voffA[2], voffB[2];
#pragma unroll
    for (int i = 0; i < 2; ++i) { int R, C; stage_rc(tid * 16 + i * 8192, R, C); const int Rb = Epi::PERM ? ((R & ~31) + perm32(R & 31)) : R;
        voffA[i] = (unsigned)(R * K + C) * 2u; voffB[i] = (unsigned)(Rb * K + C) * 2u; }
    const size_t kstep = (size_t)(BK * 2);
    const size_t hstep = (size_t)HALF * K * 2;
    const size_t tstep = 2 * hstep;
    const unsigned ldsw = (unsigned)wid * 1024u;
#define PG8_SA(b, h) (((b) * 2 + (h)) * HTB)
#define PG8_SB(b, h) ((4 + (b) * 2 + (h)) * HTB)
#define PG8_STAGE(bufoff, gbase, voff) do { _Pragma("unroll") for (int _i = 0; _i < 2; ++_i) \
        __builtin_amdgcn_global_load_lds((const unsigned*)((const char*)(gbase) + (voff)[_i]), (PG8_LAS unsigned*)(lds + (bufoff) + ldsw + _i * 8192), 16, 0, 0); } while (0)
#define PG8_LDA(dst, b, h) do { _Pragma("unroll") for (int m = 0; m < 4; ++m) _Pragma("unroll") for (int k = 0; k < 2; ++k) dst[m][k] = *(const PG8_LAS bf16x8*)(lds + PG8_SA(b, h) + aoff + m * 2048 + k * 1024); } while (0)
#define PG8_LDB(dst, b, h) do { _Pragma("unroll") for (int n = 0; n < 2; ++n) _Pragma("unroll") for (int k = 0; k < 2; ++k) dst[n][k] = *(const PG8_LAS bf16x8*)(lds + PG8_SB(b, h) + boff + n * 2048 + k * 1024); } while (0)
#define PG8_MMA(ai, bj, At, Bt) do { __builtin_amdgcn_s_setprio(1); _Pragma("unroll") for (int m = 0; m < 4; ++m) _Pragma("unroll") for (int n = 0; n < 2; ++n) _Pragma("unroll") for (int k = 0; k < 2; ++k) \
        acc[ai][bj][m][n] = __builtin_amdgcn_mfma_f32_16x16x32_bf16(Bt[n][k], At[m][k], acc[ai][bj][m][n], 0, 0, 0); __builtin_amdgcn_s_setprio(0); } while (0)
#define PG8_WAIT_V(n) asm volatile("s_waitcnt vmcnt(" #n ")" ::: "memory")
#define PG8_WAIT_L(n) asm volatile("s_waitcnt lgkmcnt(" #n ")" ::: "memory")
#define PG8_BAR __builtin_amdgcn_s_barrier()
#define PG8_SCHED __builtin_amdgcn_sched_barrier(0)
    Unit cur, nxt; int ui = 0;
    if (!S.next(0, cur)) return;
    f32x4 acc[2][2][4][2];
#pragma unroll
    for (int a = 0; a < 2; ++a)
#pragma unroll
        for (int b = 0; b < 2; ++b)
#pragma unroll
            for (int m = 0; m < 4; ++m)
#pragma unroll
                for (int n = 0; n < 2; ++n) acc[a][b][m][n] = (f32x4){0.f, 0.f, 0.f, 0.f};
    bf16x8 At[4][2], B0[2][2], B1[2][2];
    const char* cA = (const char*)g.A + (size_t)cur.pm * tstep; const char* cB = (const char*)g.Bt + (size_t)cur.pn * tstep;
    S.a_ready(cur);
    if constexpr (SP2) {
        PG8_STAGE(PG8_SB(0, 0), cB, voffB); PG8_STAGE(PG8_SB(0, 1), cB + hstep, voffB); PG8_STAGE(PG8_SA(0, 0), cA, voffA); PG8_STAGE(PG8_SA(0, 1), cA + hstep, voffA);
        if (wr == 1) PG8_BAR;
        PG8_WAIT_V(2); PG8_BAR;
        PG8_STAGE(PG8_SB(1, 0), cB + kstep, voffB); PG8_STAGE(PG8_SA(1, 0), cA + kstep, voffA); PG8_STAGE(PG8_SB(1, 1), cB + hstep + kstep, voffB);
        PG8_WAIT_V(6); PG8_BAR;
    } else {
        PG8_STAGE(PG8_SB(0, 0), cB, voffB); PG8_STAGE(PG8_SA(0, 0), cA, voffA); PG8_STAGE(PG8_SB(0, 1), cB + hstep, voffB); PG8_STAGE(PG8_SA(0, 1), cA + hstep, voffA);
        if (wr == 1) PG8_BAR;
        PG8_WAIT_V(4); PG8_BAR;
        PG8_STAGE(PG8_SB(1, 0), cB + kstep, voffB); PG8_STAGE(PG8_SA(1, 0), cA + kstep, voffA); PG8_STAGE(PG8_SB(1, 1), cB + hstep + kstep, voffB);
        PG8_WAIT_V(6); PG8_BAR;
    }
    for (;;) {
        const bool has_next = S.next(ui + 1, nxt);
        const char* nA = has_next ? (const char*)g.A + (size_t)nxt.pm * tstep : cA; const char* nB = has_next ? (const char*)g.Bt + (size_t)nxt.pn * tstep : cB;
        for (int t = 0; t < nt; t += 2) {
            unsigned zk_ = 0u; asm volatile("" : "+v"(zk_)); const int lk_ = (int)__builtin_amdgcn_mbcnt_hi(~0u, __builtin_amdgcn_mbcnt_lo(~0u, zk_));
            const int aoff = lds_byte(wr * 64 + (lk_ & 15), (lk_ >> 4) * 8), boff = lds_byte(wc * 32 + (lk_ & 15), (lk_ >> 4) * 8);
            const bool last = (t == nt - 2);
            const char* a1 = cA + (size_t)(t + 1) * kstep;
            const char* a2 = last ? nA : cA + (size_t)(t + 2) * kstep; const char* b2 = last ? nB : cB + (size_t)(t + 2) * kstep;
            const char* a3 = a2 + kstep; const char* b3 = b2 + kstep;
            if (last && has_next) S.a_ready(nxt);
            if constexpr (SP2) {
            PG8_LDB(B0, 0, 0); PG8_LDB(B1, 0, 1); PG8_SCHED; PG8_LDA(At, 0, 0); PG8_STAGE(PG8_SA(1, 1), a1 + hstep, voffA);
            PG8_WAIT_V(8); PG8_WAIT_L(0); PG8_BAR; PG8_MMA(0, 0, At, B0); PG8_MMA(0, 1, At, B1); PG8_BAR; PG8_SCHED;
            PG8_LDA(At, 0, 1); PG8_STAGE(PG8_SB(0, 0), b2, voffB); PG8_STAGE(PG8_SB(0, 1), b2 + hstep, voffB); PG8_STAGE(PG8_SA(0, 0), a2, voffA);
            PG8_WAIT_V(8); PG8_WAIT_L(0); PG8_BAR; PG8_MMA(1, 0, At, B0); PG8_MMA(1, 1, At, B1); PG8_BAR; PG8_SCHED;
            PG8_LDB(B0, 1, 0); PG8_LDB(B1, 1, 1); PG8_SCHED; PG8_LDA(At, 1, 0); PG8_STAGE(PG8_SA(0, 1), a2 + hstep, voffA);
            PG8_WAIT_V(8); PG8_WAIT_L(0); PG8_BAR; PG8_MMA(0, 0, At, B0); PG8_MMA(0, 1, At, B1); PG8_BAR; PG8_SCHED;
            PG8_LDA(At, 1, 1); PG8_STAGE(PG8_SB(1, 0), b3, voffB); PG8_STAGE(PG8_SB(1, 1), b3 + hstep, voffB); PG8_STAGE(PG8_SA(1, 0), a3, voffA);
            PG8_WAIT_V(8); PG8_WAIT_L(0); PG8_BAR; PG8_MMA(1, 0, At, B0); PG8_MMA(1, 1, At, B1); PG8_BAR; PG8_SCHED;
            } else {
            PG8_LDB(B0, 0, 0); PG8_SCHED; PG8_LDA(At, 0, 0); PG8_STAGE(PG8_SA(1, 1), a1 + hstep, voffA);
            PG8_WAIT_L(8); PG8_BAR; PG8_WAIT_L(0); PG8_MMA(0, 0, At, B0); PG8_BAR; PG8_SCHED;
            PG8_LDB(B1, 0, 1); PG8_STAGE(PG8_SB(0, 0), b2, voffB);
            PG8_BAR; PG8_WAIT_L(0); PG8_MMA(0, 1, At, B1); PG8_BAR;
            PG8_LDA(At, 0, 1); PG8_STAGE(PG8_SA(0, 0), a2, voffA);
            PG8_BAR; PG8_WAIT_L(0); PG8_MMA(1, 0, At, B0); PG8_BAR; PG8_SCHED;
            PG8_STAGE(PG8_SB(0, 1), b2 + hstep, voffB);
            PG8_WAIT_V(6); PG8_BAR; PG8_MMA(1, 1, At, B1); PG8_BAR;
            PG8_LDB(B0, 1, 0); PG8_SCHED; PG8_LDA(At, 1, 0); PG8_STAGE(PG8_SA(0, 1), a2 + hstep, voffA);
            PG8_WAIT_L(8); PG8_BAR; PG8_WAIT_L(0); PG8_MMA(0, 0, At, B0); PG8_BAR; PG8_SCHED;
            PG8_LDB(B1, 1, 1); PG8_STAGE(PG8_SB(1, 0), b3, voffB);
            PG8_BAR; PG8_WAIT_L(0); PG8_MMA(0, 1, At, B1); PG8_BAR;
            PG8_LDA(At, 1, 1); PG8_STAGE(PG8_SA(1, 0), a3, voffA);
            PG8_BAR; PG8_WAIT_L(0); PG8_MMA(1, 0, At, B0); PG8_BAR; PG8_SCHED;
            PG8_STAGE(PG8_SB(1, 1), b3 + hstep, voffB);
            PG8_WAIT_V(6); PG8_BAR; PG8_MMA(1, 1, At, B1); PG8_BAR;
            }
        }
        if constexpr (ALIGN_EPI) { if (wr == 0) PG8_BAR; }
        if constexpr (!Epi::AFTER_DRAIN) { unsigned z_ = 0u; asm volatile("" : "+v"(z_)); const int ln_ = (int)__builtin_amdgcn_mbcnt_hi(~0u, __builtin_amdgcn_mbcnt_lo(~0u, z_));
            E(acc, cur, wr, wc, ln_ & 15, ln_ >> 4); S.done(cur); }
        if (!has_next) break;
#pragma unroll
        for (int a = 0; a < 2; ++a)
#pragma unroll
            for (int b = 0; b < 2; ++b)
#pragma unroll
                for (int m = 0; m < 4; ++m)
#pragma unroll
                    for (int n = 0; n < 2; ++n) acc[a][b][m][n] = (f32x4){0.f, 0.f, 0.f, 0.f};
        cur = nxt; cA = nA; cB = nB; ++ui;
        if constexpr (ALIGN_EPI) { if (wr == 1) PG8_BAR; }
    }
    PG8_WAIT_V(0);
    if constexpr (!ALIGN_EPI) { if (wr == 0) PG8_BAR; }
    PG8_BAR;
    if constexpr (Epi::AFTER_DRAIN) { E.fused(acc, cur, wr, wc, fr, fq, lds, wid, lane); S.done(cur); }
#undef PG8_SA
#undef PG8_SB
#undef PG8_STAGE
#undef PG8_LDA
#undef PG8_LDB
#undef PG8_MMA
#undef PG8_WAIT_V
#undef PG8_WAIT_L
#undef PG8_BAR
#undef PG8_SCHED
}
}
__device__ __forceinline__ void ph_mod(const int wv, float* lds) {
    float* sc = lds;
    float* red = lds + 8192;
    float* MODp = (float*)(wsp() + WS_MOD);
    const int tid = otid(wv);
    for (int i = tid; i < 8192; i += NTHR) { const float v = inp(I_C)[i]; sc[i] = v / (1.f + expf(-v)); }
    __syncthreads();
    const int cl = tid & 63, kq = tid >> 6;
    for (int u = obx(); u < DEPTH * 96; u += ogx()) {
        const int l = u / 96, col = (u % 96) * 64 + cl;
        const float* W = inp(I_ADAW) + (size_t)l * DM * 6144 + col;
        float acc[8] = {0, 0, 0, 0, 0, 0, 0, 0};
        for (int k = kq * 128; k < kq * 128 + 128; k += 16) { float w[16];
#pragma unroll
            for (int i = 0; i < 16; ++i) w[i] = *(const GAS float*)(unsigned long long)(W + (size_t)(k + i) * 6144);
            SCHED_FENCE();
#pragma unroll
            for (int i = 0; i < 16; ++i)
#pragma unroll
                for (int b = 0; b < 8; ++b) acc[b] = fmaf(sc[b * 1024 + k + i], w[i], acc[b]); }
        __syncthreads();
#pragma unroll
        for (int b = 0; b < 8; ++b) red[(kq * 8 + b) * 64 + cl] = acc[b];
        __syncthreads();
        { const int b = tid >> 6; float s = inp(I_ADAB)[l * 6144 + col];
#pragma unroll
          for (int q = 0; q < 8; ++q) s += red[(q * 8 + b) * 64 + cl];
          MODp[((size_t)l * 8 + b) * 6144 + col] = s; }
    }
    __syncthreads();
}

__device__ __forceinline__ int rope_perm(int j) { const int g = j >> 3, w = j & 7; return (w < 4) ? 4 * g + w : 16 + 4 * g + (w - 4); }
__device__ __forceinline__ int win_src(int n) {
    if (n < 1088) return n;
    if (n < 1856) return n - 1088 + 1508;
    if (n < 2112) return n - 1856 + 1092;
    if (n < 2240) return n - 2112 + 1348;
    if (n < 2272) return 1476 + rope_perm(n - 2240);
    if (n < 2528) return n - 2272 + 2280;
    if (n < 2532) return n - 2528 + 1088;
    if (n < 2536) return n - 2532 + 2276;
    return -1;
}
__device__ __forceinline__ int wuq_src(int n) { if (n >= 384) return -1; const int hh = n / 96, e = n % 96; return (e < 64) ? n : hh * 96 + 64 + rope_perm(e - 64); }
template <int MAP>
__device__ __forceinline__ void wconv_item(const float* W, int K, int N, bf16_t* WT, int Kpad, float* scr, int item, int nblk, int lane) {
    const int kb = item / nblk, nb = item % nblk, k0 = 64 * kb, n0 = 32 * nb;
    const int n = n0 + (lane & 31); int ns = (MAP == 1) ? win_src(n) : (MAP == 2) ? wuq_src(n) : n; if (ns >= N) ns = -1;
    float wl_[32]; const int nsc = ns < 0 ? 0 : ns;
#pragma unroll
    for (int i = 0; i < 32; ++i) { const int kk = 2 * i + (lane >> 5); const int kc = (k0 + kk < K) ? k0 + kk : 0; wl_[i] = *(const GAS float*)(unsigned long long)(W + (size_t)kc * N + nsc); }
    SCHED_FENCE();
#pragma unroll
    for (int i = 0; i < 32; ++i) { const int kk = 2 * i + (lane >> 5); scr[kk * 33 + (lane & 31)] = (ns >= 0 && k0 + kk < K) ? wl_[i] : 0.f; }
    __builtin_amdgcn_wave_barrier(); asm volatile("s_waitcnt lgkmcnt(0)" ::: "memory");
    const int c = lane & 7;
#pragma unroll
    for (int j = 0; j < 4; ++j) { const int nn = (lane >> 3) + 8 * j; const float* s = scr + (8 * c) * 33 + nn;
        v4u o; o.x = pk2(s[0 * 33], s[1 * 33]); o.y = pk2(s[2 * 33], s[3 * 33]); o.z = pk2(s[4 * 33], s[5 * 33]); o.w = pk2(s[6 * 33], s[7 * 33]);
        *(v4u*)(WT + (size_t)(n0 + nn) * Kpad + k0 + 8 * c) = o; }
    __builtin_amdgcn_wave_barrier(); asm volatile("s_waitcnt lgkmcnt(0)" ::: "memory");
}
__device__ __forceinline__ void ph_wconv(const int wv, float* lds) {
    const int tid_ = otid(wv); const int lane = tid_ & 63, wave = __builtin_amdgcn_readfirstlane(tid_ >> 6);
    float* scr = lds + wave * (64 * 33);
    constexpr int I0 = 16 * 80, I1 = 16 * 32, I2 = 16 * 64, I3 = 4 * 16, I4 = 4 * 16, I5 = 4 * 8, IL = I0 + I1 + I2 + I3 + I4 + I5;
    for (int it = obx() * NWAVES + wave; it < DEPTH * IL; it += ogx() * NWAVES) {
        const int l = it / IL; int r = it % IL;
        if (r < I0) { wconv_item<1>(inp(I_WIN) + (size_t)l * 1024 * INW, 1024, INW, (bf16_t*)(wsp() + WS_WIN) + (size_t)l * 2560 * 1024, 1024, scr, r, 80, lane); continue; } r -= I0;
        if (r < I1) { wconv_item<0>(inp(I_WOUT) + (size_t)l * 1024 * 1024, 1024, 1024, (bf16_t*)(wsp() + WS_WOUT) + (size_t)l * 1024 * 1024, 1024, scr, r, 32, lane); continue; } r -= I1;
        if (r < I2) { wconv_item<0>(inp(I_PWQ) + (size_t)l * 1024 * 2048, 1024, 2048, (bf16_t*)(wsp() + WS_WPQ) + (size_t)l * 2048 * 1024, 1024, scr, r, 64, lane); continue; } r -= I2;
        if (r < I3) { wconv_item<2>(inp(I_WUQ) + (size_t)l * 256 * 384, 256, 384, (bf16_t*)(wsp() + WS_WUQ) + (size_t)l * 512 * 256, 256, scr, r, 16, lane); continue; } r -= I3;
        if (r < I4) { wconv_item<0>(inp(I_WUKV) + (size_t)l * 128 * 512, 128, 512, (bf16_t*)(wsp() + WS_WUKV) + (size_t)l * 512 * 256, 256, scr, r, 16, lane); continue; } r -= I4;
        wconv_item<0>(inp(I_SWGLU) + (size_t)l * 256 * 256, 256, 256, (bf16_t*)(wsp() + WS_WGLU) + (size_t)l * 256 * 256, 256, scr, r, 8, lane);
    }
    { bf16_t* SKB = (bf16_t*)(wsp() + WS_SKB);
      for (int i = obx() * NTHR + tid_; i < DEPTH * 2 * 128 * 128 / 2; i += ogx() * NTHR) { const int l2 = i >> 14, c = (i >> 13) & 1, rem = i & 8191;
          const float* sp = (c == 0 ? inp(I_SK1) : inp(I_SK2)) + (size_t)l2 * 16384 + 2 * rem; *(unsigned*)(SKB + 2 * (size_t)i) = pk2(sp[0], sp[1]); } }
    float* ROPE = (float*)(wsp() + WS_ROPE); const int* POSp = (const int*)inp(I_POS);
    for (int i = obx() * NTHR + tid_; i < T * 16; i += ogx() * NTHR) { const int r = i >> 4, d = i & 15;
        const float freq = powf(10000.f, -(float)d / 16.f); const float ang = (float)POSp[r] * freq; float sn, cs; sincosf(ang, &sn, &cs); ROPE[2 * i] = cs; ROPE[2 * i + 1] = sn; }
}

template <bool XBF> __device__ __forceinline__ void ph_modnorm(const int wv, const void* Xv, const float* g, const float* mod_sh, const float* mod_sc, bf16_t* H) {
    const int tid_ = otid(wv); const int lane = tid_ & 63, wave = __builtin_amdgcn_readfirstlane(tid_ >> 6);
    v4f gg[4];
#pragma unroll
    for (int j = 0; j < 4; ++j) gg[j] = *(const GAS v4f*)(unsigned long long)(g + lane * 4 + 256 * j);
    constexpr int RPT = XBF ? 4 : 2;
    for (int r0 = (obx() * NWAVES + wave) * RPT; r0 < T; r0 += ogx() * NWAVES * RPT) {
        const int b = r0 / SEQ; v4f v[RPT][4], sc[4], sh[4];
#pragma unroll
        for (int i = 0; i < RPT; ++i)
#pragma unroll
            for (int j = 0; j < 4; ++j) { if constexpr (XBF) { const v2u xb = *(const GAS v2u*)(unsigned long long)((const bf16_t*)Xv + (size_t)(r0 + i) * DM + lane * 4 + 256 * j); v[i][j] = (v4f){bf_lo(xb.x), bf_hi(xb.x), bf_lo(xb.y), bf_hi(xb.y)}; }
                else v[i][j] = *(const GAS v4f*)(unsigned long long)((const float*)Xv + (size_t)(r0 + i) * DM + lane * 4 + 256 * j); }
#pragma unroll
        for (int j = 0; j < 4; ++j) { sc[j] = *(const GAS v4f*)(unsigned long long)(mod_sc + (size_t)b * 6144 + lane * 4 + 256 * j); sh[j] = *(const GAS v4f*)(unsigned long long)(mod_sh + (size_t)b * 6144 + lane * 4 + 256 * j); }
        SCHED_FENCE();
#pragma unroll
        for (int i = 0; i < RPT; ++i) { float s = 0.f;
#pragma unroll
            for (int j = 0; j < 4; ++j) s += v[i][j].x * v[i][j].x + v[i][j].y * v[i][j].y + v[i][j].z * v[i][j].z + v[i][j].w * v[i][j].w;
            const float rs = rsqrtf(wave_sum(s) * (1.f / DM) + EPS);
#pragma unroll
            for (int j = 0; j < 4; ++j) { const v4f x = v[i][j];
                *(uint2*)(H + (size_t)(r0 + i) * DM + lane * 4 + 256 * j) = make_uint2(pk2(x.x * rs * gg[j].x * (1.f + sc[j].x) + sh[j].x, x.y * rs * gg[j].y * (1.f + sc[j].y) + sh[j].y), pk2(x.z * rs * gg[j].z * (1.f + sc[j].z) + sh[j].z, x.w * rs * gg[j].w * (1.f + sc[j].w) + sh[j].w)); }
        }
    }
}

__device__ __forceinline__ void ph_mla_norms(const int wv, const float* gq, const float* gkv) {
    const int tid_ = otid(wv); const int lane = tid_ & 63, wave = __builtin_amdgcn_readfirstlane(tid_ >> 6);
    const float* PF = (const float*)(wsp() + WS_PF32); bf16_t* QNp = (bf16_t*)(wsp() + WS_QN); bf16_t* KVNp = (bf16_t*)(wsp() + WS_KVN);
    const float4 g4 = ld4(gq + 4 * lane); const float2 g2 = *(const float2*)(gkv + 2 * lane);
    for (int r0 = (obx() * NWAVES + wave) * 2; r0 < T; r0 += ogx() * NWAVES * 2) {
        v4f a[2]; v2f c[2];
#pragma unroll
        for (int i = 0; i < 2; ++i) { a[i] = *(const GAS v4f*)(unsigned long long)(PF + (size_t)(r0 + i) * 704 + 4 * lane); c[i] = *(const GAS v2f*)(unsigned long long)(PF + (size_t)(r0 + i) * 704 + 256 + 2 * lane); }
        SCHED_FENCE();
#pragma unroll
        for (int i = 0; i < 2; ++i) {
            const float rq = rsqrtf(wave_sum(a[i].x * a[i].x + a[i].y * a[i].y + a[i].z * a[i].z + a[i].w * a[i].w) * (1.f / 256.f) + EPS);
            const float rk = rsqrtf(wave_sum(c[i].x * c[i].x + c[i].y * c[i].y) * (1.f / 128.f) + EPS);
            *(uint2*)(QNp + (size_t)(r0 + i) * 256 + 4 * lane) = make_uint2(pk2(a[i].x * rq * g4.x, a[i].y * rq * g4.y), pk2(a[i].z * rq * g4.z, a[i].w * rq * g4.w));
            *(unsigned*)(KVNp + (size_t)(r0 + i) * 256 + 2 * lane) = pk2(c[i].x * rk * g2.x, c[i].y * rk * g2.y);
            *(unsigned*)(KVNp + (size_t)(r0 + i) * 256 + 128 + 2 * lane) = 0u; }
    }
}

__device__ __forceinline__ void ph_krope(const int wv) {
    const int tid = otid(wv);
    const float* PF = (const float*)(wsp() + WS_PF32); const float* ROPE = (const float*)(wsp() + WS_ROPE); bf16_t* KRB = (bf16_t*)(wsp() + WS_KRB);
    for (int i = obx() * NTHR + tid; i < T * 4; i += ogx() * NTHR) { const int r = i >> 2, g = i & 3;
        const float4 x1 = ld4(PF + (size_t)r * 704 + 384 + 8 * g), x2 = ld4(PF + (size_t)r * 704 + 384 + 8 * g + 4);
        const float4 cs0 = ld4(ROPE + (size_t)r * 32 + 8 * g), cs1 = ld4(ROPE + (size_t)r * 32 + 8 * g + 4);
        v4u o; o.x = pk2(x1.x * cs0.x - x2.x * cs0.y, x1.y * cs0.z - x2.y * cs0.w); o.y = pk2(x1.z * cs1.x - x2.z * cs1.y, x1.w * cs1.z - x2.w * cs1.w);
        o.z = pk2(x1.x * cs0.y + x2.x * cs0.x, x1.y * cs0.w + x2.y * cs0.z); o.w = pk2(x1.z * cs1.y + x2.z * cs1.x, x1.w * cs1.w + x2.w * cs1.z);
        *(v4u*)(KRB + (size_t)r * 32 + 8 * g) = o; }
}

__device__ __forceinline__ int row_sum_dpp(int c) {
    c += __builtin_amdgcn_update_dpp(0, c, 0xB1, 0xF, 0xF, false); c += __builtin_amdgcn_update_dpp(0, c, 0x4E, 0xF, 0xF, false);
    c += __builtin_amdgcn_update_dpp(0, c, 0x141, 0xF, 0xF, false); c += __builtin_amdgcn_update_dpp(0, c, 0x140, 0xF, 0xF, false); return c; }
__device__ __forceinline__ int wave_count(int c) { c = row_sum_dpp(c); return __builtin_amdgcn_readlane(c, 0) + __builtin_amdgcn_readlane(c, 16) + __builtin_amdgcn_readlane(c, 32) + __builtin_amdgcn_readlane(c, 48); }
template <int NR>
__device__ __forceinline__ void dsa_emit(const unsigned (&key)[NR], const unsigned tau, const int t, unsigned long long* mrow, const int lane) {
    unsigned long long mine = 0ull;
    if (t + 1 <= 256) {
#pragma unroll
        for (int j = 0; j < NR; ++j) { const unsigned long long m = __ballot(key[j] != 0u); mine = (lane == j) ? m : mine; }
    } else {
        int cgt = 0;
#pragma unroll
        for (int j = 0; j < NR; ++j) cgt += __popcll(__ballot(key[j] > tau));
        int need = 256 - cgt;
#pragma unroll
        for (int j = 0; j < NR; ++j) {
            unsigned long long mg = __ballot(key[j] > tau), me = __ballot(key[j] == tau);
            const int c = __popcll(me);
            if (c <= need) { mg |= me; need -= c; }
            else { while (need > 0) { const unsigned long long low = me & (~me + 1ull); mg |= low; me ^= low; --need; } }
            mine = (lane == j) ? mg : mine;
        }
    }
    if (lane < 32) mrow[lane] = mine;
}
template <int NR>
__device__ __forceinline__ void dsa_select2(const LAS unsigned* SqA, const LAS unsigned* SqB, const int nwA, const int nwB, const int tA, const int tB, unsigned long long* mrowA, unsigned long long* mrowB, const int lane) {
    unsigned ka[NR], kb[NR];
#pragma unroll
    for (int j = 0; j < NR; ++j) { ka[j] = (j < nwA) ? SqA[64 * j] : 0u; kb[j] = (j < nwB) ? SqB[64 * j] : 0u; }
    unsigned tauA = 0u, tauB = 0u; bool doneA = (tA + 1 <= 256), doneB = (tB + 1 <= 256);
    for (int bit = 31; bit >= 0 && !(doneA && doneB); --bit) {
        const unsigned candA = tauA | (1u << bit), candB = tauB | (1u << bit); int ca = 0, cb = 0;
#pragma unroll
        for (int j = 0; j < NR; ++j) { asm("v_cmp_ge_u32_e32 vcc, %1, %2\n\tv_addc_co_u32_e32 %0, vcc, 0, %0, vcc" : "+v"(ca) : "v"(ka[j]), "v"(candA) : "vcc");
                                       asm("v_cmp_ge_u32_e32 vcc, %1, %2\n\tv_addc_co_u32_e32 %0, vcc, 0, %0, vcc" : "+v"(cb) : "v"(kb[j]), "v"(candB) : "vcc"); }
        const int cntA = wave_count(ca), cntB = wave_count(cb);
        if (!doneA) { if (cntA >= 256) tauA = candA; if (cntA == 256) doneA = true; }
        if (!doneB) { if (cntB >= 256) tauB = candB; if (cntB == 256) doneB = true; }
    }
    dsa_emit<NR>(ka, tauA, tA, mrowA, lane); dsa_emit<NR>(kb, tauB, tB, mrowB, lane);
}
__device__ __forceinline__ void ph_dsa_mask(const int wv, LAS unsigned char* L) {
    typedef short bf16x8 __attribute__((ext_vector_type(8))); typedef float f32x4 __attribute__((ext_vector_type(4)));
    constexpr int SROW = 2052;
    const int tid = otid(wv); const int lane = tid & 63, wave = __builtin_amdgcn_readfirstlane(tid >> 6), q16 = lane & 15, kg = lane >> 4;
    const bf16_t* PBF = (const bf16_t*)(wsp() + WS_PBF); const float* PF = (const float*)(wsp() + WS_PF32);
    unsigned long long* MASK = (unsigned long long*)(wsp() + WS_MASK);
    LAS unsigned* S = (LAS unsigned*)L;
    for (int unit = obx(); unit < T / 16; unit += ogx()) {
        const int ug = unit & 127, ub = unit >> 7, tg = ((unit / ogx()) & 1) ? 127 - ug : ug;
        const int r0 = ub * SEQ + tg * 16, b = ub, t0 = tg * 16, tmax = t0 + 15, ntile = ((tmax >> 6) + 1) * 4;
        __syncthreads();
        {   bf16x8 qf[4][2]; float w[4];
            const bf16_t* qp = PBF + (size_t)(r0 + q16) * 1856 + 768 + 8 * kg;
#pragma unroll
            for (int h = 0; h < 4; ++h) { qf[h][0] = *(const bf16x8*)(qp + 64 * h); qf[h][1] = *(const bf16x8*)(qp + 64 * h + 32); }
            { const float4 wq = ld4(PF + (size_t)(r0 + q16) * 704 + 672); w[0] = wq.x; w[1] = wq.y; w[2] = wq.z; w[3] = wq.w; }
            const int tq = t0 + q16;
            for (int tb = wave; tb < ntile; tb += 32) {
                bf16x8 k0[4], k1[4];
#pragma unroll
                for (int u4 = 0; u4 < 4; ++u4) { const int tile = (tb + 8 * u4 < ntile) ? tb + 8 * u4 : tb; const bf16_t* kp = PBF + (size_t)(b * SEQ + tile * 16 + q16) * 1856 + 1024 + 8 * kg;
                    k0[u4] = __builtin_bit_cast(bf16x8, ldg16(kp)); k1[u4] = __builtin_bit_cast(bf16x8, ldg16(kp + 32)); }
                SCHED_FENCE();
#pragma unroll
                for (int u4 = 0; u4 < 4; ++u4) { const int tile = tb + 8 * u4;
                    f32x4 sc = {0.f, 0.f, 0.f, 0.f};
#pragma unroll
                    for (int h = 0; h < 4; ++h) { f32x4 d = {0.f, 0.f, 0.f, 0.f};
                        d = __builtin_amdgcn_mfma_f32_16x16x32_bf16(k0[u4], qf[h][0], d, 0, 0, 0); d = __builtin_amdgcn_mfma_f32_16x16x32_bf16(k1[u4], qf[h][1], d, 0, 0, 0);
#pragma unroll
                        for (int j = 0; j < 4; ++j) sc[j] = fmaf(w[h], fmaxf(d[j], 0.f), sc[j]); }
                    v4u ko;
#pragma unroll
                    for (int j = 0; j < 4; ++j) { const float s0 = sc[j] + 0.f; const unsigned ub = __float_as_uint(s0); unsigned kk = (ub & 0x80000000u) ? ~ub : (ub | 0x80000000u); if (kk == 0u) kk = 1u;
                        ko[j] = (tile * 16 + 4 * kg + j <= tq) ? kk : 0u; }
                    if (tile < ntile) *(LAS v4u*)(S + q16 * SROW + tile * 16 + 4 * kg) = ko; }
            }
        }
        __syncthreads();
        {   const int qA = 2 * wave, qB = qA + 1, tA = t0 + qA, tB = t0 + qB, nwB = (tB >> 6) + 1, nwA = (tA >> 6) + 1;
            unsigned long long* mrA = MASK + (size_t)(r0 + qA) * 32; unsigned long long* mrB = MASK + (size_t)(r0 + qB) * 32;
            if (nwB <= 8) dsa_select2<8>(S + qA * SROW + lane, S + qB * SROW + lane, nwA, nwB, tA, tB, mrA, mrB, lane);
            else if (nwB <= 16) dsa_select2<16>(S + qA * SROW + lane, S + qB * SROW + lane, nwA, nwB, tA, tB, mrA, mrB, lane);
            else if (nwB <= 24) dsa_select2<24>(S + qA * SROW + lane, S + qB * SROW + lane, nwA, nwB, tA, tB, mrA, mrB, lane);
            else dsa_select2<32>(S + qA * SROW + lane, S + qB * SROW + lane, nwA, nwB, tA, tB, mrA, mrB, lane);
        }
    }
    __syncthreads();
}

__device__ __forceinline__ void ph_fox_cum(const int wv, int l, LAS unsigned char* L) {
    const int tid = otid(wv); const int lane = tid & 63, wave = __builtin_amdgcn_readfirstlane(tid >> 6);
    const float* PF = (const float*)(wsp() + WS_PF32); float* CUM = (float*)(wsp() + WS_CUM);
    LAS float* WT = (LAS float*)(L + 143360);
    for (int u = obx(); u < NB * 4; u += ogx()) {
        const int b = u >> 2, h = u & 3; const float bf = inp(I_FOXB)[l * 4 + h];
        float v[4];
#pragma unroll
        for (int j = 0; j < 4; ++j) { const float z = PF[(size_t)(b * SEQ + 4 * tid + j) * 704 + 676 + h] + bf; v[j] = fminf(z, 0.f) - log1pf(expf(-fabsf(z))); }
        v[1] += v[0]; v[2] += v[1]; v[3] += v[2];
        float s = v[3];
#pragma unroll
        for (int o = 1; o < 64; o <<= 1) { const float n = bperm(s, lane - o); if (lane >= o) s += n; }
        __syncthreads();
        if (lane == 63) WT[wave] = s;
        __syncthreads();
        float off = s - v[3];
        for (int w2 = 0; w2 < wave; ++w2) off += WT[w2];
        *(float4*)(CUM + (size_t)(b * 4 + h) * SEQ + 4 * tid) = make_float4(v[0] + off, v[1] + off, v[2] + off, v[3] + off);
    }
    __syncthreads();
}

struct S5Coef { float are, aim, bbre[16], bbim[16]; };
__device__ __forceinline__ void s5_coef(S5Coef& k, int l, int g, int p) {
    const float lre = inp(I_SARE)[(l * 16 + g) * 64 + p], lim = inp(I_SAIM)[(l * 16 + g) * 64 + p];
    const float dt = expf(inp(I_SLDT)[l * 16 + g]); const float mag = expf(lre * dt);
    k.are = mag * cosf(lim * dt); k.aim = mag * sinf(lim * dt);
    const float den = lre * lre + lim * lim;
    const float cre = ((k.are - 1.f) * lre + k.aim * lim) / den, cim = (k.aim * lre - (k.are - 1.f) * lim) / den;
    const float* Br = inp(I_SBRE) + (((size_t)l * 16 + g) * 64 + p) * 16; const float* Bi = inp(I_SBIM) + (((size_t)l * 16 + g) * 64 + p) * 16;
#pragma unroll
    for (int h = 0; h < 16; h += 4) { const float4 br = ld4(Br + h), bi = ld4(Bi + h);
        k.bbre[h] = cre * br.x - cim * bi.x; k.bbim[h] = cre * bi.x + cim * br.x; k.bbre[h + 1] = cre * br.y - cim * bi.y; k.bbim[h + 1] = cre * bi.y + cim * br.y;
        k.bbre[h + 2] = cre * br.z - cim * bi.z; k.bbim[h + 2] = cre * bi.z + cim * br.z; k.bbre[h + 3] = cre * br.w - cim * bi.w; k.bbim[h + 3] = cre * bi.w + cim * br.w; }
}
#define S5_STEP(UT, tt) do { const v4f u0 = *(const LAS v4f*)((UT) + 16 * (tt)), u1 = *(const LAS v4f*)((UT) + 16 * (tt) + 4), u2 = *(const LAS v4f*)((UT) + 16 * (tt) + 8), u3 = *(const LAS v4f*)((UT) + 16 * (tt) + 12); \
    float bre = u0.x * K.bbre[0], bim = u0.x * K.bbim[0]; \
    bre = fmaf(u0.y, K.bbre[1], bre); bim = fmaf(u0.y, K.bbim[1], bim); bre = fmaf(u0.z, K.bbre[2], bre); bim = fmaf(u0.z, K.bbim[2], bim); bre = fmaf(u0.w, K.bbre[3], bre); bim = fmaf(u0.w, K.bbim[3], bim); \
    bre = fmaf(u1.x, K.bbre[4], bre); bim = fmaf(u1.x, K.bbim[4], bim); bre = fmaf(u1.y, K.bbre[5], bre); bim = fmaf(u1.y, K.bbim[5], bim); bre = fmaf(u1.z, K.bbre[6], bre); bim = fmaf(u1.z, K.bbim[6], bim); bre = fmaf(u1.w, K.bbre[7], bre); bim = fmaf(u1.w, K.bbim[7], bim); \
    bre = fmaf(u2.x, K.bbre[8], bre); bim = fmaf(u2.x, K.bbim[8], bim); bre = fmaf(u2.y, K.bbre[9], bre); bim = fmaf(u2.y, K.bbim[9], bim); bre = fmaf(u2.z, K.bbre[10], bre); bim = fmaf(u2.z, K.bbim[10], bim); bre = fmaf(u2.w, K.bbre[11], bre); bim = fmaf(u2.w, K.bbim[11], bim); \
    bre = fmaf(u3.x, K.bbre[12], bre); bim = fmaf(u3.x, K.bbim[12], bim); bre = fmaf(u3.y, K.bbre[13], bre); bim = fmaf(u3.y, K.bbim[13], bim); bre = fmaf(u3.z, K.bbre[14], bre); bim = fmaf(u3.z, K.bbim[14], bim); bre = fmaf(u3.w, K.bbre[15], bre); bim = fmaf(u3.w, K.bbim[15], bim); \
    const float nre = fmaf(K.are, xre, fmaf(-K.aim, xim, bre)), nim = fmaf(K.are, xim, fmaf(K.aim, xre, bim)); xre = nre; xim = nim; } while (0)
constexpr int S5_WREG = 12800, S5_CT = 8192 + 16384;
__device__ __forceinline__ void s5_load_u(LAS float* UT, const float* PF, int b, int g, int c, int lane) {
    const float* up = PF + (size_t)(b * SEQ + c * 64 + lane) * 704 + 416 + g * 16;
    const float4 a0 = ld4(up), a1 = ld4(up + 4), a2 = ld4(up + 8), a3 = ld4(up + 12);
    __builtin_amdgcn_wave_barrier();
    *(LAS v4f*)(UT + 16 * lane) = (v4f){a0.x, a0.y, a0.z, a0.w}; *(LAS v4f*)(UT + 16 * lane + 4) = (v4f){a1.x, a1.y, a1.z, a1.w}; *(LAS v4f*)(UT + 16 * lane + 8) = (v4f){a2.x, a2.y, a2.z, a2.w}; *(LAS v4f*)(UT + 16 * lane + 12) = (v4f){a3.x, a3.y, a3.z, a3.w};
    __builtin_amdgcn_wave_barrier();
}
__device__ __forceinline__ void ph_s5_pass1(const int wv, int l, LAS unsigned char* L) {
    const int tid = otid(wv), lane = tid & 63, wave = __builtin_amdgcn_readfirstlane(tid >> 6);
    const float* PF = (const float*)(wsp() + WS_PF32); float* E = (float*)(wsp() + WS_S5E);
    LAS float* UT = (LAS float*)(L + S5_CT + wave * S5_WREG);
    for (int unit = obx(); unit < 256; unit += ogx()) {
        const int bg = unit >> 1, half = unit & 1, b = bg >> 4, g = bg & 15;
        S5Coef K; s5_coef(K, l, g, lane);
        for (int cc = 0; cc < 2; ++cc) { const int c = half * 16 + wave * 2 + cc;
            s5_load_u(UT, PF, b, g, c, lane);
            float xre = 0.f, xim = 0.f;
#pragma unroll 8
            for (int tt = 0; tt < 64; ++tt) S5_STEP(UT, tt);
            *(float2*)(E + ((size_t)(bg * 32 + c) * 64 + lane) * 2) = make_float2(xre, xim);
        }
    }
}
__device__ __forceinline__ void ph_s5_pass2(const int wv, int l, LAS unsigned char* L) {
    const int tid = otid(wv), lane = tid & 63, wave = __builtin_amdgcn_readfirstlane(tid >> 6);
    const float* PF = (const float*)(wsp() + WS_PF32); const float* E = (const float*)(wsp() + WS_S5E);
    float* SGp = (float*)(wsp() + WS_SG); bf16_t* SGBp = (bf16_t*)(wsp() + WS_SGB);
    LAS float* CT = (LAS float*)L; LAS float* EL = (LAS float*)(L + 8192); LAS float* UT = (LAS float*)(L + S5_CT + wave * S5_WREG); LAS float* XT = UT + 1024;
    for (int unit = obx(); unit < 256; unit += ogx()) {
        const int bg = unit >> 1, half = unit & 1, b = bg >> 4, g = bg & 15;
        __syncthreads();
        for (int i = tid; i < 1024; i += NTHR) { const int h = i >> 6, p = i & 63;
            CT[p * 16 + h] = inp(I_SCRE)[((size_t)l * 16 + g) * 1024 + i]; CT[1024 + p * 16 + h] = -inp(I_SCIM)[((size_t)l * 16 + g) * 1024 + i]; }
        for (int i = tid; i < 4096; i += NTHR) EL[i] = E[(size_t)bg * 4096 + i];
        __syncthreads();
        S5Coef K; s5_coef(K, l, g, lane);
        float aLre, aLim;
        { const float lre = inp(I_SARE)[(l * 16 + g) * 64 + lane], lim = inp(I_SAIM)[(l * 16 + g) * 64 + lane]; const float dt = expf(inp(I_SLDT)[l * 16 + g]);
          const float mg = expf(64.f * lre * dt); aLre = mg * cosf(64.f * lim * dt); aLim = mg * sinf(64.f * lim * dt); }
        const int t16 = lane & 15, hq = lane >> 4;
        const float Dh = inp(I_SD)[l * 256 + g * 16 + t16];
        for (int cc = 0; cc < 2; ++cc) { const int c = half * 16 + wave * 2 + cc;
            float xre = 0.f, xim = 0.f;
            for (int cp = 0; cp < c; ++cp) { const float ex = EL[(cp * 64 + lane) * 2], ey = EL[(cp * 64 + lane) * 2 + 1];
                const float nre = aLre * xre - aLim * xim + ex, nim = aLre * xim + aLim * xre + ey; xre = nre; xim = nim; }
            s5_load_u(UT, PF, b, g, c, lane);
            for (int sub = 0; sub < 4; ++sub) {
#pragma unroll 8
                for (int tt = 0; tt < 16; ++tt) { S5_STEP(UT, sub * 16 + tt); XT[tt * 130 + lane] = xre; XT[tt * 130 + 65 + lane] = xim; }
                __builtin_amdgcn_wave_barrier();
                v4f acc = {0.f, 0.f, 0.f, 0.f};
#pragma unroll
                for (int s = 0; s < 32; ++s) { const int kk = 4 * s + hq;
                    acc = __builtin_amdgcn_mfma_f32_16x16x4f32(XT[t16 * 130 + kk + (s >= 16 ? 1 : 0)], CT[kk * 16 + t16], acc, 0, 0, 0); }
                float y[4];
#pragma unroll
                for (int j = 0; j < 4; ++j) { const float v = acc[j] + Dh * UT[16 * (sub * 16 + 4 * hq + j) + t16], z2 = 1.5957691216057308f * (v + 0.044715f * v * v * v); y[j] = v / (1.f + __expf(-z2)); }
#pragma unroll
                for (int j = 0; j < 4; ++j) { const size_t o = (size_t)(b * SEQ + c * 64 + sub * 16 + 4 * hq + j) * 256 + g * 16 + t16; SGp[o] = y[j]; SGBp[o] = (bf16_t)f2bf(y[j]); }
                __builtin_amdgcn_wave_barrier();
            }
        }
    }
    __syncthreads();
}

namespace att {
typedef short bf16x8 __attribute__((ext_vector_type(8)));
typedef short s16x4 __attribute__((ext_vector_type(4)));
typedef float f32x16 __attribute__((ext_vector_type(16)));
typedef float f32x4 __attribute__((ext_vector_type(4)));
typedef int i32x4 __attribute__((ext_vector_type(4)));
constexpr int KBUF = 64 * 208, VPITCH = 136, VBUF = 64 * VPITCH, BTB = 512, BUFSZ = KBUF + VBUF + BTB;
constexpr int TB_OFF = 4 * BUFSZ, TBP = 132, Q_OFF = TB_OFF + 4 * TBP * 4;
constexpr float LOG2E = 1.4426950408889634f;
__device__ __forceinline__ unsigned cvtpk(float lo, float hi) { unsigned r; asm volatile("v_cvt_pk_bf16_f32 %0, %1, %2" : "=v"(r) : "v"(lo), "v"(hi)); return r; }
__device__ __forceinline__ float halves_max(float v) { auto rr = __builtin_amdgcn_permlane32_swap(__float_as_uint(v), __float_as_uint(v), false, false); return fmaxf(__uint_as_float(rr[0]), __uint_as_float(rr[1])); }
__device__ __forceinline__ float halves_sum(float v) { auto rr = __builtin_amdgcn_permlane32_swap(__float_as_uint(v), __float_as_uint(v), false, false); return __uint_as_float(rr[0]) + __uint_as_float(rr[1]); }

struct Ptrs { const bf16_t* PBF; const bf16_t* QB; const bf16_t* KVB; const bf16_t* KRB; const float* ROPE; const float* CUM; const unsigned long long* MASK; const int* POS; float* GRP; };

template <int MODE>
__device__ __forceinline__ void unit(const int tid, const int b, const int h, const int qb, LAS unsigned char* L, const Ptrs& P) {
    constexpr int DK = (MODE == 1) ? 96 : 64, ND = DK / 16, KROW = DK * 2 + 16, KCH = DK / 8;
    const float cscale = (MODE == 1 ? 0.10206207261596577f : 0.125f) * LOG2E;
    const int lane = tid & 63, r32 = lane & 31, hi = lane >> 5, wid = __builtin_amdgcn_readfirstlane(tid >> 6);
    const int qw0 = 256 * qb + 32 * wid, q = qw0 + r32;
    const unsigned rowq = (unsigned)(b * SEQ + q);
    bf16x8 qf[ND];
    { const bf16_t* qrow = (MODE == 1) ? P.QB + (size_t)rowq * 384 + h * 96 : P.PBF + (size_t)rowq * 1856 + (MODE == 0 ? 0 : 1088) + 64 * h;
#pragma unroll
      for (int d0 = 0; d0 < ND; ++d0) qf[d0] = __builtin_bit_cast(bf16x8, ldg16(qrow + 16 * d0 + 8 * hi));
      if (MODE == 1) {
#pragma unroll
          for (int d0 = 0; d0 < 4; ++d0) { const v4u w = __builtin_bit_cast(v4u, qf[d0]); v4u o;
              o.x = cvtpk(bf_lo(w.x) * cscale, bf_hi(w.x) * cscale); o.y = cvtpk(bf_lo(w.y) * cscale, bf_hi(w.y) * cscale); o.z = cvtpk(bf_lo(w.z) * cscale, bf_hi(w.z) * cscale); o.w = cvtpk(bf_lo(w.w) * cscale, bf_hi(w.w) * cscale);
              qf[d0] = __builtin_bit_cast(bf16x8, o); }
#pragma unroll
          for (int d0 = 4; d0 < ND; ++d0) { const int g = 2 * (d0 - 4) + hi; const f32x4 cs0 = *(const f32x4*)(P.ROPE + (size_t)rowq * 32 + 8 * g), cs1 = *(const f32x4*)(P.ROPE + (size_t)rowq * 32 + 8 * g + 4);
              const v4u w = __builtin_bit_cast(v4u, qf[d0]);
              const float a0 = bf_lo(w.x) * cscale, a1 = bf_hi(w.x) * cscale, a2 = bf_lo(w.y) * cscale, a3 = bf_hi(w.y) * cscale, b0 = bf_lo(w.z) * cscale, b1 = bf_hi(w.z) * cscale, b2 = bf_lo(w.w) * cscale, b3 = bf_hi(w.w) * cscale;
              v4u o; o.x = cvtpk(a0 * cs0[0] - b0 * cs0[1], a1 * cs0[2] - b1 * cs0[3]); o.y = cvtpk(a2 * cs1[0] - b2 * cs1[1], a3 * cs1[2] - b3 * cs1[3]);
              o.z = cvtpk(a0 * cs0[1] + b0 * cs0[0], a1 * cs0[3] + b1 * cs0[2]); o.w = cvtpk(a2 * cs1[1] + b2 * cs1[0], a3 * cs1[3] + b3 * cs1[2]);
              qf[d0] = __builtin_bit_cast(bf16x8, o); } } }
    const int NT = 4 * (qb + 1);
    const int kr0 = tid / KCH, kc0 = tid % KCH, kr1 = (tid + 512) / KCH, kc1 = (tid + 512) % KCH;
    const bf16_t* ksrc0 = (MODE == 1) ? ((kc0 < 8) ? P.KVB + (size_t)(b * SEQ + kr0) * 512 + h * 128 + 8 * kc0 : P.KRB + (size_t)(b * SEQ + kr0) * 32 + 8 * (kc0 - 8))
                                      : P.PBF + (size_t)(b * SEQ + kr0) * 1856 + (MODE == 0 ? 256 : 1344) + 64 * h + 8 * kc0;
    const bf16_t* ksrc1 = (MODE == 1) ? ((kc1 < 8) ? P.KVB + (size_t)(b * SEQ + kr1) * 512 + h * 128 + 8 * kc1 : P.KRB + (size_t)(b * SEQ + kr1) * 32 + 8 * (kc1 - 8)) : nullptr;
    const size_t kstep0 = (size_t)64 * ((MODE == 1) ? ((kc0 < 8) ? 512 : 32) : 1856), kstep1 = (size_t)64 * ((kc1 < 8) ? 512 : 32);
    const size_t vpitch = (MODE == 1) ? 512 : 1856;
    const bf16_t* vsrc = ((MODE == 1) ? P.KVB + h * 128 + 64 : P.PBF + (MODE == 0 ? 512 : 1600) + 64 * h) + (size_t)(b * SEQ + (tid >> 3)) * vpitch + 8 * (tid & 7);
    const unsigned kdst0 = kr0 * KROW + kc0 * 16, kdst1 = kr1 * KROW + kc1 * 16, vdst = KBUF + (8 * (tid & 7)) * VPITCH + 2 * (tid >> 3);
#define ATT_VWRITE(BASE) do { LAS unsigned char* vp_ = (BASE) + vdst; \
        *(LAS bf16_t*)(vp_) = (bf16_t)vreg.x; *(LAS bf16_t*)(vp_ + VPITCH) = (bf16_t)(vreg.x >> 16); *(LAS bf16_t*)(vp_ + 2 * VPITCH) = (bf16_t)vreg.y; *(LAS bf16_t*)(vp_ + 3 * VPITCH) = (bf16_t)(vreg.y >> 16); \
        *(LAS bf16_t*)(vp_ + 4 * VPITCH) = (bf16_t)vreg.z; *(LAS bf16_t*)(vp_ + 5 * VPITCH) = (bf16_t)(vreg.z >> 16); *(LAS bf16_t*)(vp_ + 6 * VPITCH) = (bf16_t)vreg.w; *(LAS bf16_t*)(vp_ + 7 * VPITCH) = (bf16_t)(vreg.w >> 16); } while (0)
    float cumq = 0.f; int posq = 0, posq_min = 0;
    if (MODE == 2) cumq = P.CUM[(size_t)(b * 4 + h) * SEQ + q];
    if (MODE == 0) { posq = P.POS[rowq]; int pm = posq; pm = min(pm, __builtin_amdgcn_ds_swizzle(pm, (1 << 10) | 0x1F)); pm = min(pm, __builtin_amdgcn_ds_swizzle(pm, (2 << 10) | 0x1F)); pm = min(pm, __builtin_amdgcn_ds_swizzle(pm, (4 << 10) | 0x1F));
        pm = min(pm, __builtin_amdgcn_ds_swizzle(pm, (8 << 10) | 0x1F)); pm = min(pm, __builtin_amdgcn_ds_swizzle(pm, (16 << 10) | 0x1F)); posq_min = __builtin_amdgcn_readlane(pm, 0); }
    const unsigned long long* mrow = (MODE == 0) ? P.MASK + (size_t)rowq * 32 : nullptr;

    float m = 0.f, l = 0.f; f32x16 o0 = {}, o1 = {};
    f32x16 negm = {}; asm volatile("" : "+v"(negm));
    constexpr float INV_CS = (MODE == 1) ? 1.f : (1.f / (0.125f * LOG2E));
    v4u kreg0, kreg1 = {0u, 0u, 0u, 0u}, vreg; float breg = 0.f;
    v4u kregB0, kregB1 = {0u, 0u, 0u, 0u}, vregB; float bregB = 0.f;
    kreg0 = ldg16(ksrc0); if (MODE == 1 && tid < 256) kreg1 = ldg16(ksrc1); vreg = ldg16(vsrc);
    if (MODE == 2 && tid < 64) breg = -LOG2E * P.CUM[(size_t)(b * 4 + h) * SEQ + tid];
    if (MODE == 0 && tid < 64) breg = __int_as_float(P.POS[b * SEQ + tid]);
    kregB0 = ldg16(ksrc0 + kstep0); if (MODE == 1 && tid < 256) kregB1 = ldg16(ksrc1 + kstep1); vregB = ldg16(vsrc + (size_t)64 * vpitch);
    if (MODE == 2 && tid < 64) bregB = -LOG2E * P.CUM[(size_t)(b * 4 + h) * SEQ + 64 + tid];
    if (MODE == 0 && tid < 64) bregB = __int_as_float(P.POS[b * SEQ + 64 + tid]);
    SCHED_FENCE();
    __syncthreads();
    auto write_set = [&](LAS unsigned char* Bn, const v4u k0_, const v4u k1_, const v4u v_, const float b_) {
        *(LAS v4u*)(Bn + kdst0) = k0_; if (MODE == 1 && tid < 256) *(LAS v4u*)(Bn + kdst1) = k1_;
        { const v4u vreg = v_; ATT_VWRITE(Bn); }
        if (MODE != 1 && tid < 64) { *(LAS float*)(Bn + KBUF + VBUF + 4 * tid) = b_;
            if (MODE == 0) { int pmx = __float_as_int(b_); pmx = max(pmx, __builtin_amdgcn_ds_swizzle(pmx, (1 << 10) | 0x1F)); pmx = max(pmx, __builtin_amdgcn_ds_swizzle(pmx, (2 << 10) | 0x1F)); pmx = max(pmx, __builtin_amdgcn_ds_swizzle(pmx, (4 << 10) | 0x1F));
                pmx = max(pmx, __builtin_amdgcn_ds_swizzle(pmx, (8 << 10) | 0x1F)); pmx = max(pmx, __builtin_amdgcn_ds_swizzle(pmx, (16 << 10) | 0x1F)); pmx = max(__builtin_amdgcn_readlane(pmx, 0), __builtin_amdgcn_readlane(pmx, 32));
                if (tid == 0) *(LAS int*)(Bn + KBUF + VBUF + 256) = pmx; } }
    };
    write_set(L, kreg0, kreg1, vreg, breg); write_set(L + BUFSZ, kregB0, kregB1, vregB, bregB);
    __syncthreads();
    auto tile_step = [&](const int t) {
        LAS unsigned char* B = L + (t & 3) * BUFSZ;
        if ((t & 1) == 0 && t + 2 < NT) {
            kreg0 = ldg16(ksrc0 + (size_t)(t + 2) * kstep0); if (MODE == 1 && tid < 256) kreg1 = ldg16(ksrc1 + (size_t)(t + 2) * kstep1); vreg = ldg16(vsrc + (size_t)(t + 2) * 64 * vpitch);
            kregB0 = ldg16(ksrc0 + (size_t)(t + 3) * kstep0); if (MODE == 1 && tid < 256) kregB1 = ldg16(ksrc1 + (size_t)(t + 3) * kstep1); vregB = ldg16(vsrc + (size_t)(t + 3) * 64 * vpitch);
            if (MODE == 2 && tid < 64) { breg = -LOG2E * P.CUM[(size_t)(b * 4 + h) * SEQ + 64 * (t + 2) + tid]; bregB = -LOG2E * P.CUM[(size_t)(b * 4 + h) * SEQ + 64 * (t + 3) + tid]; }
            if (MODE == 0 && tid < 64) { breg = __int_as_float(P.POS[b * SEQ + 64 * (t + 2) + tid]); bregB = __int_as_float(P.POS[b * SEQ + 64 * (t + 3) + tid]); }
        }
        SCHED_FENCE();
        const int kvb = 64 * t;
        if (kvb <= qw0 + 31) {
            unsigned mlo = 0u, mhi = 0u;
            if (MODE == 0) { const unsigned long long mw = mrow[t]; mlo = (unsigned)mw >> (4 * hi); mhi = (unsigned)(mw >> 32) >> (4 * hi); }
            f32x16 p0, p1;
            const LAS unsigned char* kt = B + r32 * KROW + 16 * hi;
#pragma unroll
            for (int d0 = 0; d0 < ND; ++d0) { const bf16x8 a0 = *(const LAS bf16x8*)(kt + 32 * d0), a1 = *(const LAS bf16x8*)(kt + 32 * KROW + 32 * d0);
                if (d0 == 0) { p0 = __builtin_amdgcn_mfma_f32_32x32x16_bf16(a0, qf[0], negm, 0, 0, 0); p1 = __builtin_amdgcn_mfma_f32_32x32x16_bf16(a1, qf[0], negm, 0, 0, 0); }
                else { p0 = __builtin_amdgcn_mfma_f32_32x32x16_bf16(a0, qf[d0], p0, 0, 0, 0); p1 = __builtin_amdgcn_mfma_f32_32x32x16_bf16(a1, qf[d0], p1, 0, 0, 0); } }
            const LAS unsigned char* bt = B + KBUF + VBUF;
            if (MODE == 1) {
            } else if (MODE == 2) {
#pragma unroll
                for (int g = 0; g < 4; ++g) { const f32x4 c0 = *(const LAS f32x4*)(bt + (8 * g + 4 * hi) * 4), c1 = *(const LAS f32x4*)(bt + (32 + 8 * g + 4 * hi) * 4);
#pragma unroll
                    for (int j = 0; j < 4; ++j) { p0[4 * g + j] = fmaf(p0[4 * g + j], cscale, c0[j]); p1[4 * g + j] = fmaf(p1[4 * g + j], cscale, c1[j]); } }
            } else {
                const int pmax = *(const LAS int*)(bt + 256);
                const LAS float* tb = (const LAS float*)(L + TB_OFF) + h * TBP;
                if (posq_min - pmax >= 128) { const float bc = tb[128];
#pragma unroll
                    for (int r = 0; r < 16; ++r) { p0[r] = p0[r] * cscale + bc; p1[r] = p1[r] * cscale + bc; }
                } else {
#pragma unroll
                    for (int g = 0; g < 4; ++g) { const i32x4 k0 = *(const LAS i32x4*)(bt + (8 * g + 4 * hi) * 4), k1 = *(const LAS i32x4*)(bt + (32 + 8 * g + 4 * hi) * 4);
#pragma unroll
                        for (int j = 0; j < 4; ++j) { int n0 = posq - k0[j], n1 = posq - k1[j]; n0 = min(max(n0, 0), 128); n1 = min(max(n1, 0), 128);
                            p0[4 * g + j] = p0[4 * g + j] * cscale + tb[n0]; p1[4 * g + j] = p1[4 * g + j] * cscale + tb[n1]; } }
                }
            }
            if (kvb + 63 > qw0) {
#pragma unroll
                for (int r = 0; r < 16; ++r) { const int kv = kvb + (r & 3) + 8 * (r >> 2) + 4 * hi; if (kv > q) p0[r] = -INFINITY; if (kv + 32 > q) p1[r] = -INFINITY; }
            }
            float mx = fmaxf(p0[0], p1[0]);
#pragma unroll
            for (int r = 1; r < 16; ++r) mx = fmaxf(mx, fmaxf(p0[r], p1[r]));
            mx = halves_max(mx);
            if (t == 0 || __any(mx > 6.f)) {
                const float dl = (t == 0) ? mx : fmaxf(mx, 0.f), alpha = __builtin_amdgcn_exp2f(-dl);
                m += dl; l *= alpha;
#pragma unroll
                for (int r = 0; r < 16; ++r) { p0[r] -= dl; p1[r] -= dl; o0[r] *= alpha; o1[r] *= alpha; }
                const float nv = -m * INV_CS;
#pragma unroll
                for (int r = 0; r < 16; ++r) negm[r] = nv;
                asm volatile("" : "+v"(negm));
            }
            float sum = 0.f;
#pragma unroll
            for (int r = 0; r < 16; ++r) { float e0 = __builtin_amdgcn_exp2f(p0[r]), e1 = __builtin_amdgcn_exp2f(p1[r]);
                if (MODE == 0) { const int bitp = (r & 3) + 8 * (r >> 2);
                    e0 = __uint_as_float(__float_as_uint(e0) & (unsigned)__builtin_amdgcn_sbfe(mlo, bitp, 1)); e1 = __uint_as_float(__float_as_uint(e1) & (unsigned)__builtin_amdgcn_sbfe(mhi, bitp, 1)); }
                p0[r] = e0; p1[r] = e1; sum += e0 + e1; }
            l += sum;
            const LAS unsigned char* vt = B + KBUF + r32 * VPITCH + 8 * hi;
#pragma unroll
            for (int st = 0; st < 4; ++st) {
                v4u pw;
                if (st == 0) { pw.x = cvtpk(p0[0], p0[1]); pw.y = cvtpk(p0[2], p0[3]); pw.z = cvtpk(p0[4], p0[5]); pw.w = cvtpk(p0[6], p0[7]); }
                else if (st == 1) { pw.x = cvtpk(p0[8], p0[9]); pw.y = cvtpk(p0[10], p0[11]); pw.z = cvtpk(p0[12], p0[13]); pw.w = cvtpk(p0[14], p0[15]); }
                else if (st == 2) { pw.x = cvtpk(p1[0], p1[1]); pw.y = cvtpk(p1[2], p1[3]); pw.z = cvtpk(p1[4], p1[5]); pw.w = cvtpk(p1[6], p1[7]); }
                else { pw.x = cvtpk(p1[8], p1[9]); pw.y = cvtpk(p1[10], p1[11]); pw.z = cvtpk(p1[12], p1[13]); pw.w = cvtpk(p1[14], p1[15]); }
                const bf16x8 bfr = __builtin_bit_cast(bf16x8, pw);
                const v2u a00 = *(const LAS v2u*)(vt + 32 * st), a01 = *(const LAS v2u*)(vt + 32 * st + 16);
                const v2u a10 = *(const LAS v2u*)(vt + 32 * VPITCH + 32 * st), a11 = *(const LAS v2u*)(vt + 32 * VPITCH + 32 * st + 16);
                v4u af0 = {a00.x, a00.y, a01.x, a01.y}, af1 = {a10.x, a10.y, a11.x, a11.y};
                o0 = __builtin_amdgcn_mfma_f32_32x32x16_bf16(__builtin_bit_cast(bf16x8, af0), bfr, o0, 0, 0, 0);
                o1 = __builtin_amdgcn_mfma_f32_32x32x16_bf16(__builtin_bit_cast(bf16x8, af1), bfr, o1, 0, 0, 0);
            }
        }
        if (t & 1) {
            if (t + 1 < NT) { write_set(L + ((t + 1) & 3) * BUFSZ, kreg0, kreg1, vreg, breg); write_set(L + ((t + 2) & 3) * BUFSZ, kregB0, kregB1, vregB, bregB); }
            __syncthreads();
        }
    };
    for (int t = 0; t < NT; t += 2) { tile_step(t); tile_step(t + 1); }
    const float inv = 1.f / halves_sum(l);
    float* orow = P.GRP + (size_t)rowq * 1024 + MODE * 256 + h * 64 + 4 * hi;
#pragma unroll
    for (int g = 0; g < 4; ++g) {
        *(f32x4*)(orow + 8 * g) = (f32x4){o0[4 * g] * inv, o0[4 * g + 1] * inv, o0[4 * g + 2] * inv, o0[4 * g + 3] * inv};
        *(f32x4*)(orow + 32 + 8 * g) = (f32x4){o1[4 * g] * inv, o1[4 * g + 1] * inv, o1[4 * g + 2] * inv, o1[4 * g + 3] * inv};
    }
#undef ATT_VWRITE
}
}

__device__ __forceinline__ void ph_attention(const int wv, const int l, LAS unsigned char* L) {
    const int tid = otid(wv);
    att::Ptrs P;
    P.PBF = (const bf16_t*)(wsp() + WS_PBF); P.QB = (const bf16_t*)(wsp() + WS_QB); P.KVB = (const bf16_t*)(wsp() + WS_KVB); P.KRB = (const bf16_t*)(wsp() + WS_KRB); P.ROPE = (const float*)(wsp() + WS_ROPE);
    P.CUM = (const float*)(wsp() + WS_CUM); P.MASK = (const unsigned long long*)(wsp() + WS_MASK); P.POS = (const int*)inp(I_POS); P.GRP = (float*)(wsp() + WS_GRP);
    for (int i = tid; i < 4 * 129; i += NTHR) { const int hh = i / 129, n = i % 129; int bk;
        if (n < 16) bk = n; else { const float lr = logf((float)n / 16.f) / 2.0794415416798357f; const int lb = 16 + (int)(lr * 16.f); bk = lb < 31 ? lb : 31; }
        *((LAS float*)(L + att::TB_OFF) + hh * att::TBP + n) = inp(I_RELB)[bk * 4 + hh] * att::LOG2E; }
    unsigned* qctr = (unsigned*)(wsp() + WS_CTL) + 16384 + 64 * l;
    for (;;) {
        __syncthreads();
        if (tid == 0) *(LAS unsigned*)(L + att::Q_OFF) = __hip_atomic_fetch_add(qctr, 1u, __ATOMIC_RELAXED, __HIP_MEMORY_SCOPE_AGENT);
        __syncthreads();
        const unsigned u = __builtin_amdgcn_readfirstlane(*(LAS unsigned*)(L + att::Q_OFF));
        if (u >= 768u) break;
        const int qb = 7 - (int)(u / 96u), mode = (int)(u % 96u) / 32, bh = (int)(u % 32u), b = bh >> 2, h = bh & 3;
        int nrep = (DUP == 4) ? 2 : 1; asm volatile("" : "+s"(nrep));
        for (int rp = 0; rp < nrep; ++rp) {
        const int tidu = otid(wv);
        if (mode == 0) att::unit<0>(tidu, b, h, qb, L, P);
        else if (mode == 1) att::unit<1>(tidu, b, h, qb, L, P);
        else att::unit<2>(tidu, b, h, qb, L, P); }
    }
    __syncthreads();
}

namespace ptk {
typedef short bf16x8 __attribute__((ext_vector_type(8)));
typedef float f32x16 __attribute__((ext_vector_type(16)));
constexpr int SKP = 272;
constexpr int TL_OFF = 2 * 128 * SKP;
__device__ __forceinline__ unsigned okey(float f) { const unsigned u = __float_as_uint(f); return (u & 0x80000000u) ? ~u : (u | 0x80000000u); }
__device__ __forceinline__ float okey_inv(unsigned k) { return __uint_as_float((k & 0x80000000u) ? (k & 0x7fffffffu) : ~k); }
#define PTK_CE(x, y) do { const unsigned mx_ = max((x), (y)), mn_ = min((x), (y)); (x) = mx_; (y) = mn_; } while (0)
__device__ __forceinline__ void sort16(unsigned (&a)[16]) {
#pragma unroll
    for (int ks = 1; ks <= 4; ++ks)
#pragma unroll
        for (int js = 3; js >= 0; --js) { if (js >= ks) continue; const int k = 1 << ks, j = 1 << js;
#pragma unroll
            for (int i = 0; i < 16; ++i) { const int l = i ^ j; if (l > i) { if ((i & k) == 0) PTK_CE(a[i], a[l]); else PTK_CE(a[l], a[i]); } } }
}
__device__ __forceinline__ void merge16(unsigned (&a)[16], const unsigned (&b)[16]) {
#pragma unroll
    for (int i = 0; i < 16; ++i) a[i] = max(a[i], b[15 - i]);
#pragma unroll
    for (int js = 3; js >= 0; --js) { const int j = 1 << js;
#pragma unroll
        for (int i = 0; i < 16; ++i) { const int l = i ^ j; if (l > i) PTK_CE(a[i], a[l]); } }
}
__device__ __forceinline__ void partner16(const unsigned (&a)[16], unsigned (&p)[16], const bool hi) {
#pragma unroll
    for (int i = 0; i < 16; ++i) { auto rr = __builtin_amdgcn_permlane32_swap(a[i], a[i], false, false); p[i] = hi ? rr[0] : rr[1]; }
}
}

__device__ __forceinline__ void ph_peer_topk(const int wv, int l, LAS unsigned char* L) {
    using namespace ptk;
    const int tid = otid(wv); const int lane = tid & 63, r32 = lane & 31, wave = __builtin_amdgcn_readfirstlane(tid >> 6); const bool hi = lane >> 5;
    const bf16_t* PQ = (const bf16_t*)(wsp() + WS_PQ);
    int* PIDX = (int*)(wsp() + WS_PIDX); float* PGATE = (float*)(wsp() + WS_PGATE);
    __syncthreads();
    { const bf16_t* SKB = (const bf16_t*)(wsp() + WS_SKB) + (size_t)l * 32768; v4u tmp[8];
#pragma unroll
      for (int k8 = 0; k8 < 8; ++k8) tmp[k8] = ldg16(SKB + 8 * (size_t)(tid + 512 * k8));
      SCHED_FENCE();
#pragma unroll
      for (int k8 = 0; k8 < 8; ++k8) { const int ch = tid + 512 * k8, row = ch >> 4, cc = ch & 15; *(LAS v4u*)(L + row * SKP + 16 * cc) = tmp[k8]; } }
    __syncthreads();
    LAS unsigned* TL = (LAS unsigned*)(L + TL_OFF + wave * 8192);
    for (int task = obx() * NWAVES + wave; task < T * 8 / 32; task += ogx() * NWAVES) {
        const int th = task * 32 + r32;
        unsigned top[2][16];
#pragma unroll
        for (int c = 0; c < 2; ++c) {
            bf16x8 qf[8];
#pragma unroll
            for (int d0 = 0; d0 < 8; ++d0) qf[d0] = __builtin_bit_cast(bf16x8, ldg16(PQ + (size_t)th * 256 + c * 128 + 16 * d0 + 8 * (int)hi));
            SCHED_FENCE();
            f32x16 acc[4];
#pragma unroll
            for (int kb = 0; kb < 4; ++kb) { acc[kb] = f32x16{};
#pragma unroll
                for (int d0 = 0; d0 < 8; ++d0) { const bf16x8 af = *(const LAS bf16x8*)(L + (c * 128 + 32 * kb + r32) * SKP + 32 * d0 + 16 * (int)hi);
                    acc[kb] = __builtin_amdgcn_mfma_f32_32x32x16_bf16(af, qf[d0], acc[kb], 0, 0, 0); } }
            unsigned cur[16], nxt[16];
#pragma unroll
            for (int kb = 0; kb < 4; ++kb) {
#pragma unroll
                for (int r = 0; r < 16; ++r) { const int kidx = 32 * kb + 8 * (r >> 2) + (r & 3); nxt[r] = (okey(acc[kb][r]) & ~0x7Fu) | (unsigned)(127 - kidx - 4 * (int)hi); }
                sort16(nxt);
                if (kb == 0) {
#pragma unroll
                    for (int r = 0; r < 16; ++r) cur[r] = nxt[r];
                } else merge16(cur, nxt);
            }
            partner16(cur, nxt, hi); merge16(cur, nxt);
#pragma unroll
            for (int i = 0; i < 16; ++i) { top[c][i] = cur[i]; TL[(c * 16 + i) * 64 + lane] = cur[i]; }
        }
        float v1[16], v2[16];
#pragma unroll
        for (int i = 0; i < 16; ++i) { v1[i] = okey_inv(top[0][i] & ~0x7Fu); v2[i] = okey_inv(top[1][i] & ~0x7Fu); }
        unsigned F[16], G[16];
        { const float a = hi ? v1[1] : v1[0];
#pragma unroll
          for (int j = 0; j < 16; ++j) { const unsigned kk = (okey(a + v2[j]) & ~0xFFu) | (unsigned)(255 - j - 16 * (int)hi); F[j] = (hi && j >= 8) ? 0u : kk; } }
#pragma unroll
        for (int m = 1; m < 8; ++m) { const float a = hi ? v1[2 * m + 1] : v1[2 * m]; const int len_e = 16 / (2 * m + 1), len_o = 16 / (2 * m + 2);
#pragma unroll
            for (int j = 0; j < len_e; ++j) { unsigned x = (okey(a + v2[j]) & ~0xFFu) | (unsigned)(255 - (32 * m + j) - 16 * (int)hi); if (j >= len_o) x = hi ? 0u : x;
#pragma unroll
                for (int p = 0; p < 16; ++p) { const unsigned t = max(F[p], x); x = min(F[p], x); F[p] = t; } } }
        partner16(F, G, hi); merge16(F, G);
        float val[16], mval = okey_inv(F[0] & ~0xFFu), ssum = 0.f;
#pragma unroll
        for (int k = 0; k < 16; ++k) { val[k] = __expf(okey_inv(F[k] & ~0xFFu) - mval); ssum += val[k]; }
        const float rs = 1.f / ssum;
        int eo[8]; float go[8];
#pragma unroll
        for (int k = 0; k < 8; ++k) { unsigned f_lo = F[k], f_hi = F[k + 8]; float v_lo = val[k], v_hi = val[k + 8]; asm volatile("" : "+v"(f_lo), "+v"(f_hi), "+v"(v_lo), "+v"(v_hi));
            const unsigned fk = hi ? f_hi : f_lo; const int flat = 255 - (int)(fk & 0xFFu), ii = flat >> 4, jj = flat & 15;
            const int i1 = 127 - (int)(TL[ii * 64 + lane] & 0x7Fu), i2 = 127 - (int)(TL[(16 + jj) * 64 + lane] & 0x7Fu);
            eo[k] = i1 * 128 + i2; go[k] = (hi ? v_hi : v_lo) * rs; }
        int* po = PIDX + (size_t)th * 16 + 8 * (int)hi; float* pg = PGATE + (size_t)th * 16 + 8 * (int)hi;
        *(int4*)po = make_int4(eo[0], eo[1], eo[2], eo[3]); *(int4*)(po + 4) = make_int4(eo[4], eo[5], eo[6], eo[7]);
        *(float4*)pg = make_float4(go[0], go[1], go[2], go[3]); *(float4*)(pg + 4) = make_float4(go[4], go[5], go[6], go[7]);
    }
    __syncthreads();
}

typedef float f2 __attribute__((ext_vector_type(2)));
typedef float v2f __attribute__((ext_vector_type(2)));
typedef float v16f __attribute__((ext_vector_type(16)));
typedef unsigned v6u_t __attribute__((ext_vector_type(6)));
__device__ __forceinline__ void ph_tabconv(const int wv, const int lsel, const int vb, const int vg) {
    const int tid_ = otid(wv); const int lane = tid_ & 63, wave = __builtin_amdgcn_readfirstlane(tid_ >> 6);
    for (int r2 = vb * NWAVES + wave; r2 < 2 * 16384; r2 += 2 * vg * NWAVES) {
        v4f a[2][4]; int rw[2];
#pragma unroll
        for (int rr = 0; rr < 2; ++rr) { const int r = min(r2 + rr * vg * NWAVES, 2 * 16384 - 1); rw[rr] = r;
            const float* srcp = ((r >> 14) == 0 ? inp(I_PU) : inp(I_PV)) + (size_t)(lsel * 16384 + (r & 16383)) * 1024 + 16 * lane;
#pragma unroll
            for (int k = 0; k < 4; ++k) a[rr][k] = *(const GAS v4f*)(unsigned long long)(srcp + 4 * k); }
        float inv[2]; v16f ea, eb;
#pragma unroll
        for (int rr = 0; rr < 2; ++rr) { float am = 0.f;
#pragma unroll
            for (int k = 0; k < 4; ++k) am = fmaxf(am, fmaxf(fmaxf(fabsf(a[rr][k].x), fabsf(a[rr][k].y)), fmaxf(fabsf(a[rr][k].z), fabsf(a[rr][k].w))));
            am = wave_max(am);
            const float sc = (am > 0.f) ? 7.5f / am : 1.f; inv[rr] = (am > 0.f) ? am / 7.5f : 1.f;
#pragma unroll
            for (int k = 0; k < 4; ++k) { ea[8 * rr + 2 * k] = a[rr][k].x * sc; eb[8 * rr + 2 * k] = a[rr][k].y * sc; ea[8 * rr + 2 * k + 1] = a[rr][k].z * sc; eb[8 * rr + 2 * k + 1] = a[rr][k].w * sc; } }
        const v6u_t o = __builtin_amdgcn_cvt_scalef32_2xpk16_fp6_f32(ea, eb, 1.0f);
#pragma unroll
        for (int q = 0; q < 2; ++q) { const int r = rw[q], tab = r >> 14, le = lsel * 16384 + (r & 16383);
            unsigned char* dst = (tab == 0) ? wsp() + WS_U8 + (size_t)le * 768 + 12 * lane
                                            : wsp() + WS_V8 + ((size_t)(lsel * 8 + (lane >> 3)) * 16384 + (r & 16383)) * 128 + 12 * (lane & 7);
            *(v3u*)dst = q ? (v3u){o[3], o[4], o[5]} : (v3u){o[0], o[1], o[2]};
            if (lane == 0) ((float*)(wsp() + (tab == 0 ? WS_SU : WS_SV)))[le] = inv[q]; }
    }
}

typedef unsigned v6u __attribute__((ext_vector_type(6)));
typedef float v32f __attribute__((ext_vector_type(32)));
__device__ __forceinline__ v3u ldg12(const unsigned char* p) { return *(const GAS v3u*)(unsigned long long)p; }
__device__ __forceinline__ v32f dec32(const v3u a, const v3u b) {
    const v6u s6 = {a.x, a.y, a.z, b.x, b.y, b.z}; return __builtin_amdgcn_cvt_scalef32_pk32_f32_fp6(s6, 1.0f); }
template <int PM> __device__ __forceinline__ void ph_peer_dots(const int wv, int l) {
    const int tid_ = otid(wv); const int lane = tid_ & 63, wave = __builtin_amdgcn_readfirstlane(tid_ >> 6);
    const bf16_t* H = (const bf16_t*)(wsp() + WS_HB); float* PW = (float*)(wsp() + (PM ? WS_GRP : WS_PW));
    const int* PIDX = (const int*)(wsp() + WS_PIDX); const float* PGATE = (const float*)(wsp() + WS_PGATE);
    const unsigned char* U8 = wsp() + WS_U8 + (size_t)l * 16384 * 768 + 12 * lane; const unsigned char* V8 = wsp() + WS_V8 + (size_t)l * 16384 * 768 + 12 * lane;
    const float* SU = (const float*)(wsp() + WS_SU) + l * 16384; const float* SV = (const float*)(wsp() + WS_SV) + l * 16384;
    const float* MODp = (const float*)(wsp() + WS_MOD) + (size_t)l * 8 * 6144;
    const bool b0 = lane & 1, b1 = lane & 2, b2 = lane & 4;
    const int J = (b2 ? 1 : 0) + (b1 ? 2 : 0) + (b0 ? 4 : 0);
    for (int r = obx() * NWAVES + wave; r < T; r += ogx() * NWAVES) {
        f2 hv[8];
        { const v4u h0 = *(const v4u*)(H + (size_t)r * DM + 16 * lane), h1 = *(const v4u*)(H + (size_t)r * DM + 16 * lane + 8);
          hv[0] = (f2){bf_lo(h0.x), bf_hi(h0.x)}; hv[1] = (f2){bf_lo(h0.y), bf_hi(h0.y)}; hv[2] = (f2){bf_lo(h0.z), bf_hi(h0.z)}; hv[3] = (f2){bf_lo(h0.w), bf_hi(h0.w)};
          hv[4] = (f2){bf_lo(h1.x), bf_hi(h1.x)}; hv[5] = (f2){bf_lo(h1.y), bf_hi(h1.y)}; hv[6] = (f2){bf_lo(h1.z), bf_hi(h1.z)}; hv[7] = (f2){bf_lo(h1.w), bf_hi(h1.w)}; }
        int iv0 = PIDX[(size_t)r * 128 + lane], iv1 = PIDX[(size_t)r * 128 + 64 + lane];
        if (PM == 2) { iv0 &= 1023; iv1 &= 1023; }
        if (PM == 3) { const int xb = (obx() & 7) << 11; iv0 = (iv0 & 2047) | xb; iv1 = (iv1 & 2047) | xb; }
        if (PM == 4) { const int xb = (obx() & 3) << 12; iv0 = (iv0 & 4095) | xb; iv1 = (iv1 & 4095) | xb; }
        const float gv0 = PGATE[(size_t)r * 128 + lane], gv1 = PGATE[(size_t)r * 128 + 64 + lane];
        const float su0 = SU[iv0], su1 = SU[iv1], sv0 = SV[iv0], sv1 = SV[iv1];
        v3u uw[8];
#define PG_ISSUE_U(bt) do { _Pragma("unroll") for (int i = 0; i < 8; ++i) { const int e = __builtin_amdgcn_readlane(((bt) & 8) ? iv1 : iv0, (((bt) & 7) << 3) + i); uw[i] = ldg12(U8 + (size_t)e * 768); } SCHED_FENCE(); } while (0)
#define PG_ISSUE_V(bt) do { _Pragma("unroll") for (int i = 0; i < 8; ++i) { const int e = __builtin_amdgcn_readlane(((bt) & 8) ? iv1 : iv0, (((bt) & 7) << 3) + i); vw[i] = ldg12(V8 + (size_t)e * 768); } SCHED_FENCE(); } while (0)
        PG_ISSUE_U(0);
#pragma unroll 1
        for (int bt = 0; bt < 16; ++bt) {
            float d[8];
#pragma unroll
            for (int j = 0; j < 4; ++j) { if (PM) { d[2 * j] = __uint_as_float(uw[2 * j].x ^ uw[2 * j].y ^ uw[2 * j].z); d[2 * j + 1] = __uint_as_float(uw[2 * j + 1].x ^ uw[2 * j + 1].y ^ uw[2 * j + 1].z); continue; }
                const v32f p = dec32(uw[2 * j], uw[2 * j + 1]); f2 a0 = (f2){p[0], p[1]} * hv[0], a1 = (f2){p[16], p[17]} * hv[0];
#pragma unroll
                for (int k = 1; k < 8; ++k) { a0 += (f2){p[2 * k], p[2 * k + 1]} * hv[k]; a1 += (f2){p[16 + 2 * k], p[17 + 2 * k]} * hv[k]; }
                d[2 * j] = a0[0] + a0[1]; d[2 * j + 1] = a1[0] + a1[1]; }
            SCHED_FENCE();
            if (bt + 1 < 16) PG_ISSUE_U(bt + 1);
            float a[4], bb[2], c;
#pragma unroll
            for (int i = 0; i < 4; ++i) { const float keep = b0 ? d[i + 4] : d[i], send = b0 ? d[i] : d[i + 4]; a[i] = keep + swz<1>(send); }
#pragma unroll
            for (int i = 0; i < 2; ++i) { const float keep = b1 ? a[i + 2] : a[i], send = b1 ? a[i] : a[i + 2]; bb[i] = keep + swz<2>(send); }
            { const float keep = b2 ? bb[1] : bb[0], send = b2 ? bb[0] : bb[1]; c = keep + swz<4>(send); }
            c += swz<8>(c); c += swz<16>(c);
            { auto rr = __builtin_amdgcn_permlane32_swap(__float_as_uint(c), __float_as_uint(c), false, false); c = __uint_as_float(rr[0]) + __uint_as_float(rr[1]); }
            const int srcl = ((bt & 7) << 3) + J;
            const float mygate = bperm((bt & 8) ? gv1 : gv0, srcl), mysu = bperm((bt & 8) ? su1 : su0, srcl), mysv = bperm((bt & 8) ? sv1 : sv0, srcl);
            const float av = c * mysu, z2 = 1.5957691216057308f * (av + 0.044715f * av * av * av);
            const float wl = mygate * mysv * av / (1.f + __expf(-z2));
            if (lane < 8) PW[(size_t)r * 128 + 8 * bt + J] = wl;
        }
#undef PG_ISSUE_U
#undef PG_ISSUE_V
    }
}


__device__ __forceinline__ void ph_peer_gather(const int wv, int l, const bool dummy) {
    const int tid_ = otid(wv); const int lane = tid_ & 63, wave = __builtin_amdgcn_readfirstlane(tid_ >> 6);
    float* X = (float*)(wsp() + WS_X); const float* PW = (const float*)(wsp() + WS_PW);
    const int* PIDX = (const int*)(wsp() + WS_PIDX); const float* PGATE = (const float*)(wsp() + WS_PGATE);
    const unsigned char* U8 = wsp() + WS_U8 + (size_t)l * 16384 * 768 + 12 * lane; const unsigned char* V8 = wsp() + WS_V8 + (size_t)l * 16384 * 768 + 12 * lane;
    const float* SU = (const float*)(wsp() + WS_SU) + l * 16384; const float* SV = (const float*)(wsp() + WS_SV) + l * 16384;
    const float* MODp = (const float*)(wsp() + WS_MOD) + (size_t)l * 8 * 6144;
    const bool b0 = lane & 1, b1 = lane & 2, b2 = lane & 4;
    const int J = (b2 ? 1 : 0) + (b1 ? 2 : 0) + (b0 ? 4 : 0);
    for (int r = obx() * NWAVES + wave; r < T; r += ogx() * NWAVES) {
        f2 y[8];
#pragma unroll
        for (int k = 0; k < 8; ++k) y[k] = (f2){0.f, 0.f};
        const int iv0 = PIDX[(size_t)r * 128 + lane], iv1 = PIDX[(size_t)r * 128 + 64 + lane];
        const float w0 = PW[(size_t)r * 128 + lane], w1 = PW[(size_t)r * 128 + 64 + lane];
        v3u vA[8], vB[8];
#define PG_ISSUE(bt, vw) do { _Pragma("unroll") for (int i = 0; i < 8; ++i) { const int e = __builtin_amdgcn_readlane(((bt) & 8) ? iv1 : iv0, (((bt) & 7) << 3) + i); vw[i] = ldg12(V8 + (size_t)e * 768); } SCHED_FENCE(); } while (0)
#define PG_FMA(bt, vw) do { _Pragma("unroll") for (int j = 0; j < 4; ++j) { const float wi0 = rdl(((bt) & 8) ? w1 : w0, (((bt) & 7) << 3) + 2 * j), wi1 = rdl(((bt) & 8) ? w1 : w0, (((bt) & 7) << 3) + 2 * j + 1); \
            const v32f p = dec32(vw[2 * j], vw[2 * j + 1]); const f2 wa = (f2){wi0, wi0}, wb = (f2){wi1, wi1}; \
            _Pragma("unroll") for (int k = 0; k < 8; ++k) { y[k] += wa * (f2){p[2 * k], p[2 * k + 1]}; y[k] += wb * (f2){p[16 + 2 * k], p[17 + 2 * k]}; } } SCHED_FENCE(); } while (0)
        PG_ISSUE(0, vA);
#pragma unroll 1
        for (int bt = 0; bt < 16; bt += 2) { PG_ISSUE(bt + 1, vB); PG_FMA(bt, vA); if (bt + 2 < 16) PG_ISSUE(bt + 2, vA); PG_FMA(bt + 1, vB); }
#undef PG_ISSUE
#undef PG_FMA
        const int b = r / SEQ; const float* gp = MODp + (size_t)b * 6144 + 5120 + 16 * lane; const float* xp = X + (size_t)r * DM + 16 * lane; float* xo = (dummy ? (float*)(wsp() + WS_GRP) : X) + (size_t)r * DM + 16 * lane;
        float4 xn[4]; float ss = 0.f;
#pragma unroll
        for (int k = 0; k < 4; ++k) { const float4 g = ld4(gp + 4 * k); float4 x = ld4(xp + 4 * k);
            x.x += g.x * y[2 * k][0]; x.y += g.y * y[2 * k][1]; x.z += g.z * y[2 * k + 1][0]; x.w += g.w * y[2 * k + 1][1]; xn[k] = x; ss += x.x * x.x + x.y * x.y + x.z * x.z + x.w * x.w; }
        const float rs = rsqrtf(wave_sum(ss) * (1.f / DM) + EPS);
        if (l + 1 < DEPTH) {
            const float* g1 = inp(I_N1G) + (l + 1) * DM + 16 * lane; const float* m1 = (const float*)(wsp() + WS_MOD) + (size_t)((l + 1) * 8 + b) * 6144 + 16 * lane;
            bf16_t* ho = (dummy ? (bf16_t*)(wsp() + WS_GN) : (bf16_t*)(wsp() + WS_HB)) + (size_t)r * DM + 16 * lane;
#pragma unroll
            for (int k = 0; k < 4; ++k) { st4(xo + 4 * k, xn[k]); const float4 gg = ld4(g1 + 4 * k), sh = ld4(m1 + 4 * k), sc = ld4(m1 + 1024 + 4 * k);
                *(uint2*)(ho + 4 * k) = make_uint2(pk2(xn[k].x * rs * gg.x * (1.f + sc.x) + sh.x, xn[k].y * rs * gg.y * (1.f + sc.y) + sh.y), pk2(xn[k].z * rs * gg.z * (1.f + sc.z) + sh.z, xn[k].w * rs * gg.w * (1.f + sc.w) + sh.w)); }
        } else {
            const float* fg = inp(I_FING) + 16 * lane; float* oo = (dummy ? (float*)(wsp() + WS_GRP) : outp()) + (size_t)r * DM + 16 * lane;
#pragma unroll
            for (int k = 0; k < 4; ++k) { const float4 gg = ld4(fg + 4 * k); st4(oo + 4 * k, make_float4(xn[k].x * rs * gg.x, xn[k].y * rs * gg.y, xn[k].z * rs * gg.z, xn[k].w * rs * gg.w)); }
        }
    }
}

struct Row6 { v4u a; v2u b; };
__device__ __forceinline__ v32f dec32r(const Row6 r) { const v6u s6 = {r.a.x, r.a.y, r.a.z, r.a.w, r.b.x, r.b.y}; return __builtin_amdgcn_cvt_scalef32_pk32_f32_fp6(s6, 1.0f); }
template <int S> __device__ __forceinline__ void ph_peer_dots_tm(const int wv, int l) {
    const int tid_ = otid(wv); const int lane = tid_ & 63, wave = __builtin_amdgcn_readfirstlane(tid_ >> 6);
    const int hl = lane & 31; const bool hh = lane & 32;
    const bf16_t* H = (const bf16_t*)(wsp() + WS_HB); float* PW = (float*)(wsp() + WS_PW);
    const int* PIDX = (const int*)(wsp() + WS_PIDX); const float* PGATE = (const float*)(wsp() + WS_PGATE);
    const unsigned char* U8 = wsp() + WS_U8 + (size_t)l * 16384 * 768 + 24 * hl;
    const float* SU = (const float*)(wsp() + WS_SU) + l * 16384; const float* SV = (const float*)(wsp() + WS_SV) + l * 16384;
    const bool b0 = lane & 1, b1 = lane & 2;
    const int J = 2 * ((b0 ? 2 : 0) + (b1 ? 1 : 0)) + (hh ? 1 : 0);
    const int stride = ogx() * NWAVES;
    int r = obx() * NWAVES + wave;
    if (r < T) {
        int iv0 = PIDX[(size_t)r * 128 + lane], iv1 = PIDX[(size_t)r * 128 + 64 + lane], niv0 = iv0, niv1 = iv1;
        float gv0 = PGATE[(size_t)r * 128 + lane], gv1 = PGATE[(size_t)r * 128 + 64 + lane];
        v4u hq[4];
#pragma unroll
        for (int k = 0; k < 4; ++k) hq[k] = *(const GAS v4u*)(unsigned long long)(H + (size_t)r * DM + 32 * hl + 8 * k);
        Row6 u[S][4];
#define TM_ISSUE(uw, q) do { const int qq = (q) & 15; const int dsel = ((q) >= 16) ? ((qq & 8) ? niv1 : niv0) : ((qq & 8) ? iv1 : iv0); \
            _Pragma("unroll") for (int j = 0; j < 4; ++j) { const int el = __builtin_amdgcn_readlane(dsel, ((qq & 7) << 3) + 2 * j), eh = __builtin_amdgcn_readlane(dsel, ((qq & 7) << 3) + 2 * j + 1); \
                const unsigned char* rp = U8 + (size_t)(hh ? eh : el) * 768; uw[j].a = ldg16(rp); uw[j].b = *(const GAS v2u*)(unsigned long long)(rp + 16); } SCHED_FENCE(); } while (0)
#pragma unroll
        for (int s = 0; s < S; ++s) TM_ISSUE(u[s], s);
#pragma unroll 1
        for (; r < T; r += stride) {
            const int rn = (r + stride < T) ? r + stride : r;
            niv0 = PIDX[(size_t)rn * 128 + lane]; niv1 = PIDX[(size_t)rn * 128 + 64 + lane];
            const float ngv0 = PGATE[(size_t)rn * 128 + lane], ngv1 = PGATE[(size_t)rn * 128 + 64 + lane];
            v4u nhq[4];
#pragma unroll
            for (int k = 0; k < 4; ++k) nhq[k] = *(const GAS v4u*)(unsigned long long)(H + (size_t)rn * DM + 32 * hl + 8 * k);
            const float su0 = SU[iv0], su1 = SU[iv1], sv0 = SV[iv0], sv1 = SV[iv1];
            SCHED_FENCE();
            f2 hv[16];
#pragma unroll
            for (int k = 0; k < 4; ++k) { hv[4 * k] = (f2){bf_lo(hq[k].x), bf_hi(hq[k].x)}; hv[4 * k + 1] = (f2){bf_lo(hq[k].y), bf_hi(hq[k].y)}; hv[4 * k + 2] = (f2){bf_lo(hq[k].z), bf_hi(hq[k].z)}; hv[4 * k + 3] = (f2){bf_lo(hq[k].w), bf_hi(hq[k].w)}; }
#pragma unroll 1
            for (int bt = 0; bt < 16; bt += S) {
#pragma unroll
                for (int s = 0; s < S; ++s) {
                    float d[4];
#pragma unroll
                    for (int j = 0; j < 4; ++j) { const v32f p = dec32r(u[s][j]); f2 a0 = (f2){p[0], p[1]} * hv[0];
#pragma unroll
                        for (int k = 1; k < 16; ++k) a0 += (f2){p[2 * k], p[2 * k + 1]} * hv[k];
                        d[j] = a0[0] + a0[1]; }
                    SCHED_FENCE();
                    TM_ISSUE(u[s], bt + s + S);
                    float a2[2], c;
#pragma unroll
                    for (int i = 0; i < 2; ++i) { const float keep = b0 ? d[i + 2] : d[i], send = b0 ? d[i] : d[i + 2]; a2[i] = keep + swz<1>(send); }
                    { const float keep = b1 ? a2[1] : a2[0], send = b1 ? a2[0] : a2[1]; c = keep + swz<2>(send); }
                    c += swz<4>(c); c += swz<8>(c); c += swz<16>(c);
                    const int bb = bt + s, srcl = ((bb & 7) << 3) + J;
                    const float mygate = bperm((bb & 8) ? gv1 : gv0, srcl), mysu = bperm((bb & 8) ? su1 : su0, srcl), mysv = bperm((bb & 8) ? sv1 : sv0, srcl);
                    const float av = c * mysu, z2 = 1.5957691216057308f * (av + 0.044715f * av * av * av);
                    const float wl = mygate * mysv * av / (1.f + __expf(-z2));
                    const unsigned mye = (unsigned)__builtin_amdgcn_ds_bpermute(srcl << 2, (bb & 8) ? iv1 : iv0);
                    if ((lane & 28) == 0) ((unsigned*)PW)[(size_t)r * 128 + 8 * bb + J] = (f2bf(wl) << 16) | mye;
                }
            }
            iv0 = niv0; iv1 = niv1; gv0 = ngv0; gv1 = ngv1;
#pragma unroll
            for (int k = 0; k < 4; ++k) hq[k] = nhq[k];
        }
#undef TM_ISSUE
    }
}

__device__ __forceinline__ void ph_peer_gather_sl(const int wv, int l, LAS unsigned char* ldsb) {
    const int tid_ = otid(wv); const int lane = tid_ & 63, wave = __builtin_amdgcn_readfirstlane(tid_ >> 6);
    const int x = obx() & 7, jb = obx() >> 3, nbx = (ogx() - x + 7) >> 3;
    bf16_t* X = (bf16_t*)(wsp() + WS_X); const unsigned* PW = (const unsigned*)(wsp() + WS_PW);
    const int g = lane >> 3, s = lane & 7;
    const unsigned char* Vx = wsp() + WS_V8 + (size_t)(l * 8 + x) * 16384 * 128 + 12 * s;
    const float* MODp = (const float*)(wsp() + WS_MOD) + (size_t)l * 8 * 6144 + 5120;
    const bool g0 = lane & 8, g1 = lane & 16, g2 = lane & 32;
    const int col = 128 * x + 16 * s + (g0 ? 8 : 0) + (g1 ? 4 : 0) + (g2 ? 2 : 0);
    LAS unsigned char* mw = ldsb + wave * 1024;
    const int stride = nbx * NWAVES;
    int t = jb * NWAVES + wave;
    if (t < T) {
        v3u vA[8], vB[8];
#define SL_ISSUE(vs, i0, i1) do { vs[0] = ldg12(Vx + (size_t)(i0.x & 0xFFFFu) * 128); vs[1] = ldg12(Vx + (size_t)(i0.y & 0xFFFFu) * 128); vs[2] = ldg12(Vx + (size_t)(i0.z & 0xFFFFu) * 128); vs[3] = ldg12(Vx + (size_t)(i0.w & 0xFFFFu) * 128); \
        vs[4] = ldg12(Vx + (size_t)(i1.x & 0xFFFFu) * 128); vs[5] = ldg12(Vx + (size_t)(i1.y & 0xFFFFu) * 128); vs[6] = ldg12(Vx + (size_t)(i1.z & 0xFFFFu) * 128); vs[7] = ldg12(Vx + (size_t)(i1.w & 0xFFFFu) * 128); SCHED_FENCE(); } while (0)
#define SL_FMA(vs, w0, w1) do { _Pragma("unroll") for (int j = 0; j < 4; ++j) { const float wi0 = __uint_as_float((j < 2 ? w0 : w1)[(2 * j) & 3] & 0xFFFF0000u), wi1 = __uint_as_float((j < 2 ? w0 : w1)[(2 * j + 1) & 3] & 0xFFFF0000u); \
            const v32f p = dec32(vs[2 * j], vs[2 * j + 1]); const f2 wa = (f2){wi0, wi0}, wb = (f2){wi1, wi1}; \
            _Pragma("unroll") for (int k = 0; k < 8; ++k) { y[k] += wa * (f2){p[2 * k], p[2 * k + 1]}; y[k] += wb * (f2){p[16 + 2 * k], p[17 + 2 * k]}; } } SCHED_FENCE(); } while (0)
        { const v2u mi = *(const GAS v2u*)(unsigned long long)(PW + (size_t)t * 128 + 2 * lane); *(LAS v2u*)(mw + 8 * lane) = mi; }
        { const v4u ia = *(const LAS v4u*)(mw + 64 * g), ib = *(const LAS v4u*)(mw + 64 * g + 16); SL_ISSUE(vA, ia, ib); }
        int slot = 0;
#pragma unroll 1
        for (; t < T; t += stride) {
            const int tn = min(t + stride, T - 1);
            const v2u mi = *(const GAS v2u*)(unsigned long long)(PW + (size_t)tn * 128 + 2 * lane);
            const int b = t / SEQ;
            const unsigned xvb = *(const GAS unsigned*)(unsigned long long)(X + (size_t)t * DM + col); const v2f gt = *(const GAS v2f*)(unsigned long long)(MODp + (size_t)b * 6144 + col);
            SCHED_FENCE();
            LAS unsigned char* ms = mw + slot * 512; LAS unsigned char* mn = mw + (slot ^ 1) * 512;
            { const v4u ic = *(const LAS v4u*)(ms + 64 * g + 32), id = *(const LAS v4u*)(ms + 64 * g + 48); SL_ISSUE(vB, ic, id); }
            f2 y[8];
#pragma unroll
            for (int k = 0; k < 8; ++k) y[k] = (f2){0.f, 0.f};
            { const v4u w0 = *(const LAS v4u*)(ms + 64 * g), w1 = *(const LAS v4u*)(ms + 64 * g + 16); SL_FMA(vA, w0, w1); }
            *(LAS v2u*)(mn + 8 * lane) = mi;
            { const v4u ia = *(const LAS v4u*)(mn + 64 * g), ib = *(const LAS v4u*)(mn + 64 * g + 16); SL_ISSUE(vA, ia, ib); }
            { const v4u w2 = *(const LAS v4u*)(ms + 64 * g + 32), w3 = *(const LAS v4u*)(ms + 64 * g + 48); SL_FMA(vB, w2, w3); }
            f2 a4[4], b2[2];
#pragma unroll
            for (int k = 0; k < 4; ++k) { const f2 keep = g0 ? y[k + 4] : y[k], send = g0 ? y[k] : y[k + 4]; a4[k] = keep + (f2){swz<8>(send[0]), swz<8>(send[1])}; }
#pragma unroll
            for (int k = 0; k < 2; ++k) { const f2 keep = g1 ? a4[k + 2] : a4[k], send = g1 ? a4[k] : a4[k + 2]; b2[k] = keep + (f2){swz<16>(send[0]), swz<16>(send[1])}; }
            const f2 keep = g2 ? b2[1] : b2[0], send = g2 ? b2[0] : b2[1];
            const f2 c = keep + (f2){bperm(send[0], lane ^ 32), bperm(send[1], lane ^ 32)};
            *(unsigned*)(X + (size_t)t * DM + col) = pk2(bf_lo(xvb) + gt[0] * c[0], bf_hi(xvb) + gt[1] * c[1]);
            slot ^= 1;
        }
#undef SL_ISSUE
#undef SL_FMA
    }
}
__device__ __forceinline__ void ph_finalnorm(const int wv, const bf16_t* X, const float* g, float* O) {
    const int tid_ = otid(wv); const int lane = tid_ & 63, wave = __builtin_amdgcn_readfirstlane(tid_ >> 6);
    v4f gg[4];
#pragma unroll
    for (int j = 0; j < 4; ++j) gg[j] = *(const GAS v4f*)(unsigned long long)(g + lane * 4 + 256 * j);
    for (int r0 = (obx() * NWAVES + wave) * 4; r0 < T; r0 += ogx() * NWAVES * 4) {
        v4f v[4][4];
#pragma unroll
        for (int i = 0; i < 4; ++i)
#pragma unroll
            for (int j = 0; j < 4; ++j) { const v2u xb = *(const GAS v2u*)(unsigned long long)(X + (size_t)(r0 + i) * DM + lane * 4 + 256 * j); v[i][j] = (v4f){bf_lo(xb.x), bf_hi(xb.x), bf_lo(xb.y), bf_hi(xb.y)}; }
        SCHED_FENCE();
#pragma unroll
        for (int i = 0; i < 4; ++i) { float sq = 0.f;
#pragma unroll
            for (int j = 0; j < 4; ++j) sq += v[i][j].x * v[i][j].x + v[i][j].y * v[i][j].y + v[i][j].z * v[i][j].z + v[i][j].w * v[i][j].w;
            const float rs = rsqrtf(wave_sum(sq) * (1.f / DM) + EPS);
#pragma unroll
            for (int j = 0; j < 4; ++j) { const v4f xx = v[i][j]; *(v4f*)(O + (size_t)(r0 + i) * DM + lane * 4 + 256 * j) = (v4f){xx.x * rs * gg[j].x, xx.y * rs * gg[j].y, xx.z * rs * gg[j].z, xx.w * rs * gg[j].w}; }
        }
    }
}

constexpr int PH_PER_LAYER = 13, N_PHASES = 1 + DEPTH * PH_PER_LAYER + 1;
__device__ __forceinline__ bool in_range(int k, int lo, int hi) { asm volatile("" : "+s"(lo), "+s"(hi)); return lo <= k && k < hi; }
__global__ void __launch_bounds__(NTHR, 2) fwd(Args a) {
    float* lds = (float*)lds_raw;
    const int wv = __builtin_amdgcn_readfirstlane((int)(threadIdx.x >> 6));
    { const int t = threadIdx.x; if (t < 34) { unsigned long long p = (t < 32) ? (unsigned long long)a.in[t] : (t == 32 ? (unsigned long long)a.ws : (unsigned long long)a.out);
        *(LAS unsigned long long*)((LAS unsigned char*)lds_raw + PTAB_OFF + 8 * t) = p; } }
    volatile LAS unsigned* stw = (volatile LAS unsigned*)(LAS unsigned char*)(lds_raw + LDS_BYTES - 16);
    if (threadIdx.x == 0) { stw[0] = 0u; stw[1] = 0u; }
    __syncthreads();
    XcdBarrier bar; bar.bar = (unsigned*)(wsp() + WS_CTL) + 4096; bar.x = 0; bar.st = stw;
    const int lo = a.ph_lo, hi = a.ph_hi;
    if (hi - lo > 1) bar = xcd_barrier_post((unsigned*)(wsp() + WS_CTL) + 4096, stw);
#define IN(k) in_range((k), lo, hi)
#define SEAM(k) do { if (IN(k) && IN((k) + 1)) xcd_barrier(bar); } while (0)
#define MOD ((float*)(wsp() + WS_MOD))
#define HB ((bf16_t*)(wsp() + WS_HB))
#define PF32 ((float*)(wsp() + WS_PF32))
#define XC ((bf16_t*)(wsp() + WS_X))
#define GRP ((float*)(wsp() + WS_GRP))
#define QN ((bf16_t*)(wsp() + WS_QN))
#define KVN ((bf16_t*)(wsp() + WS_KVN))
#define GN ((bf16_t*)(wsp() + WS_GN))
#define SGB ((bf16_t*)(wsp() + WS_SGB))
#define SG ((float*)(wsp() + WS_SG))
    PG8_LAS unsigned char* ldsl = (PG8_LAS unsigned char*)lds_raw;
    if (IN(0)) { REPS(100) { ph_mod(wv, lds); ph_wconv(wv, lds); ph_tabconv(wv, 0, obx(), ogx()); ph_tabconv(wv, 1, obx(), ogx()); } } SEAM(0);
#pragma unroll 1
    for (int l = 0; l < DEPTH; ++l) {
        const int p0 = 1 + l * PH_PER_LAYER;

#define modl (MOD + (size_t)l * 8 * 6144)
        if (l == 0) { if (IN(p0 + 0)) REPS(0) ph_modnorm<false>(wv, inp(I_X), inp(I_N1G) + l * DM, modl + 0, modl + 1024, HB);
            SEAM(p0 + 0); }
        if (IN(p0 + 1)) REPS(1) { pg8::Gemm g{HB, (const bf16_t*)(wsp() + WS_WIN) + (size_t)l * 2560 * 1024, T, 2560, 1024}; pg8::StaticOrder S; S.init(T, 2560, ogx(), obx());
            pg8::EpiProj e{(bf16_t*)(wsp() + WS_PBF), PF32}; pg8::gemm_phase<pg8::EpiProj, pg8::StaticOrder, true, true>(ldsl, g, S, e, otid(wv)); }
        SEAM(p0 + 1);
        if (IN(p0 + 2)) {
            REPS(20) ph_s5_pass1(wv, l, (LAS unsigned char*)lds_raw);
            REPS(21) ph_dsa_mask(wv, (LAS unsigned char*)lds_raw);
            ph_mla_norms(wv, inp(I_MQG) + l * 256, inp(I_MKVG) + l * 128);
            ph_krope(wv);
            ph_fox_cum(wv, l, (LAS unsigned char*)lds_raw);
        }
        SEAM(p0 + 2);
        if (IN(p0 + 3)) REPS(3) {
            ph_s5_pass2(wv, l, (LAS unsigned char*)lds_raw);
            { pg8::Gemm g{QN, (const bf16_t*)(wsp() + WS_WUQ) + (size_t)l * 512 * 256, T, 512, 256}; pg8::StaticOrder S; S.init(T, 512, ogx(), obx());
              pg8::EpiBf16N<384, 384> e{(bf16_t*)(wsp() + WS_QB)}; pg8::gemm_phase<pg8::EpiBf16N<384, 384>, pg8::StaticOrder, true, true>(ldsl, g, S, e, otid(wv)); }
            { pg8::Gemm g{KVN, (const bf16_t*)(wsp() + WS_WUKV) + (size_t)l * 512 * 256, T, 512, 256}; pg8::StaticOrder S; S.init(T, 512, ogx(), obx());
              pg8::EpiBf16N<512, 512> e{(bf16_t*)(wsp() + WS_KVB)}; pg8::gemm_phase<pg8::EpiBf16N<512, 512>, pg8::StaticOrder, true, true>(ldsl, g, S, e, otid(wv)); }
        }
        SEAM(p0 + 3);
        if (IN(p0 + 4)) {
            { pg8::Gemm g{SGB, (const bf16_t*)(wsp() + WS_WGLU) + (size_t)l * 256 * 256, T, 256, 256}; pg8::StaticOrder S; S.init(T, 256, ogx(), obx());
              pg8::EpiF32<256, 256> e{(float*)(wsp() + WS_SZ)}; pg8::gemm_phase<pg8::EpiF32<256, 256>, pg8::StaticOrder, true, true>(ldsl, g, S, e, otid(wv)); }
            ph_attention(wv, l, (LAS unsigned char*)lds_raw);
        }
        SEAM(p0 + 4);
        if (IN(p0 + 5)) {
            const int tid = otid(wv), lane = tid & 63, wave = __builtin_amdgcn_readfirstlane(tid >> 6);
            const v4f bb = *(const GAS v4f*)(unsigned long long)(inp(I_SBGLU) + l * 256 + lane * 4);
            v4f gg[4];
#pragma unroll
            for (int g = 0; g < 4; ++g) gg[g] = *(const GAS v4f*)(unsigned long long)(inp(I_GNG) + l * DM + g * 256 + lane * 4);
            for (int r0 = (obx() * NWAVES + wave) * 2; r0 < T; r0 += ogx() * NWAVES * 2) {
                v4f v[2][4], sg[2], sz[2];
#pragma unroll
                for (int i = 0; i < 2; ++i) {
#pragma unroll
                    for (int g = 0; g < 3; ++g) v[i][g] = *(const GAS v4f*)(unsigned long long)(GRP + (size_t)(r0 + i) * DM + g * 256 + lane * 4);
                    sg[i] = *(const GAS v4f*)(unsigned long long)(SG + (size_t)(r0 + i) * 256 + lane * 4); sz[i] = *(const GAS v4f*)(unsigned long long)((const float*)(wsp() + WS_SZ) + (size_t)(r0 + i) * 256 + lane * 4); }
                SCHED_FENCE();
#pragma unroll
                for (int i = 0; i < 2; ++i) { const int r = r0 + i;
                    v[i][3] = (v4f){sg[i].x * sigmoidf_(sz[i].x + bb.x), sg[i].y * sigmoidf_(sz[i].y + bb.y), sg[i].z * sigmoidf_(sz[i].z + bb.z), sg[i].w * sigmoidf_(sz[i].w + bb.w)};
#pragma unroll
                    for (int g = 0; g < 4; ++g) { const v4f vv = v[i][g]; const float rs = rsqrtf(wave_sum(vv.x * vv.x + vv.y * vv.y + vv.z * vv.z + vv.w * vv.w) * (1.f / 256.f) + EPS);
                        *(uint2*)(GN + (size_t)r * DM + g * 256 + lane * 4) = make_uint2(pk2(vv.x * rs * gg[g].x, vv.y * rs * gg[g].y), pk2(vv.z * rs * gg[g].z, vv.w * rs * gg[g].w)); } }
            }
        }
        SEAM(p0 + 5);
        if (IN(p0 + 6)) REPS(6) { pg8::Gemm g{GN, (const bf16_t*)(wsp() + WS_WOUT) + (size_t)l * 1024 * 1024, T, 1024, 1024}; pg8::StaticOrder S; S.init(T, 1024, ogx(), obx());
            if (l == 0) { pg8::EpiResGate<false> e{inp(I_X), XC, modl + 2048}; pg8::gemm_phase<pg8::EpiResGate<false>, pg8::StaticOrder, false, true>(ldsl, g, S, e, otid(wv)); }
            else { pg8::EpiResGate<true> e{XC, XC, modl + 2048}; pg8::gemm_phase<pg8::EpiResGate<true>, pg8::StaticOrder, false, true>(ldsl, g, S, e, otid(wv)); } }
        SEAM(p0 + 6);
        if (IN(p0 + 7)) ph_modnorm<true>(wv, XC, inp(I_N2G) + l * DM, modl + 3072, modl + 4096, HB);
        SEAM(p0 + 7);
        if (IN(p0 + 8)) REPS(8) { pg8::Gemm g{HB, (const bf16_t*)(wsp() + WS_WPQ) + (size_t)l * 2048 * 1024, T, 2048, 1024}; pg8::StaticOrder S; S.init(T, 2048, ogx(), obx());
            pg8::EpiBf16N<2048, 2048> e{(bf16_t*)(wsp() + WS_PQ)}; pg8::gemm_phase<pg8::EpiBf16N<2048, 2048>, pg8::StaticOrder, true, true>(ldsl, g, S, e, otid(wv)); }
        SEAM(p0 + 8);
        if (IN(p0 + 9)) REPS(9) ph_peer_topk(wv, l, (LAS unsigned char*)lds_raw);
        SEAM(p0 + 9);
        if (IN(p0 + 10)) ph_peer_dots_tm<PA_SETS>(wv, l);
        SEAM(p0 + 10);
        if (IN(p0 + 11)) ph_peer_gather_sl(wv, l, (LAS unsigned char*)lds_raw);
        SEAM(p0 + 11);
        if (IN(p0 + 12)) { if (l + 1 < DEPTH) { const float* modn = MOD + (size_t)(l + 1) * 8 * 6144; ph_modnorm<true>(wv, XC, inp(I_N1G) + (l + 1) * DM, modn + 0, modn + 1024, HB); } else ph_finalnorm(wv, XC, inp(I_FING), outp()); }
        if (l + 1 < DEPTH) SEAM(p0 + 12);
    }
}

extern "C" void kernel_launch(void* const* d_in, const int* in_sizes, int n_in, void* d_out, int out_size, void* d_ws, size_t ws_size, hipStream_t stream) {
    static int grid = 0;
    if (grid == 0) {
        if (n_in != 32 || out_size != T * DM || ws_size < WS_END) { fprintf(stderr, "kernel_launch: unexpected shapes (n_in %d out %d ws %zu)\n", n_in, out_size, ws_size); grid = -1; return; }
        int dev = 0, cus = 0;
        if (hipGetDevice(&dev) != hipSuccess || hipDeviceGetAttribute(&cus, hipDeviceAttributeMultiprocessorCount, dev) != hipSuccess) { grid = -1; return; }
        if (hipFuncSetAttribute((const void*)fwd, hipFuncAttributeMaxDynamicSharedMemorySize, LDS_BYTES) != hipSuccess) { fprintf(stderr, "kernel_launch: hipFuncSetAttribute failed\n"); grid = -1; return; }
        int per_cu = 0;
        if (hipOccupancyMaxActiveBlocksPerMultiprocessor(&per_cu, (const void*)fwd, NTHR, LDS_BYTES) != hipSuccess || per_cu < 1) { fprintf(stderr, "kernel_launch: occupancy query says %d\n", per_cu); }
        (void)hipGetLastError();
        grid = cus;
    }
    if (grid < 0) return;
    (void)hipMemsetAsync((char*)d_ws + WS_CTL, 0, CTL_ZERO_BYTES, stream);
    Args a{};
    for (int i = 0; i < 32; ++i) a.in[i] = (const float*)d_in[i];
    a.out = (float*)d_out; a.ws = (unsigned char*)d_ws;
#if MK_MULTI
    for (int p = 0; p < N_PHASES; ++p) { a.ph_lo = p; a.ph_hi = p + 1; hipLaunchKernelGGL(fwd, dim3(grid), dim3(NTHR), LDS_BYTES, stream, a); }
#else
    a.ph_lo = 0; a.ph_hi = N_PHASES; hipLaunchKernelGGL(fwd, dim3(grid), dim3(NTHR), LDS_BYTES, stream, a);
#endif
}
```
